# Optimizing an MI355X kernel written in HIP

```python
import math
import numpy as np
import jax, jax.numpy as jnp
from jax import lax

D_MODEL = 1024
BATCH = 8
SEQ = 8192
DEPTH = 1

HEAD_DIM = 64
NSA_HEADS = 8
NSA_KV_HEADS = 2
NSA_GROUP = NSA_HEADS // NSA_KV_HEADS
CMP_LEN = 32
CMP_STRIDE = 16
CMP_HID = 128
SLC_LEN = 64
SLC_TOPN = 16
WINDOW = 512
DSA_HEADS = 8
DSA_KV_RANK = 128
IDX_HEADS = 8
IDX_DIM = 64
DSA_TOPK_MAX = 256
N_EXPERTS = 32
MOE_TOPK = 4
D_EXPERT = 1024
SWIGLU_LIMIT = 7.0
SWIGLU_ALPHA = 1.702
REL_BUCKETS = 32
REL_MAX_DIST = 128
N_BIAS_HEADS = NSA_HEADS + DSA_HEADS
Q_BLOCK = 128
MOE_ROW_BLOCK = 128
NORM_EPS = 1e-6
NEG = -1e30

kernel_name = 'hybrid_nsa_dsa_moe_block'


def _in_widths():
    kv = NSA_KV_HEADS * HEAD_DIM
    return (NSA_HEADS * HEAD_DIM, kv, kv, kv, kv, kv, kv, NSA_HEADS * 3,
            DSA_HEADS * HEAD_DIM, DSA_KV_RANK, IDX_HEADS * IDX_DIM, IDX_DIM, IDX_HEADS,
            D_MODEL, D_MODEL)


def _split_offsets():
    offs, acc = [], 0
    for w in _in_widths()[:-1]:
        acc += w
        offs.append(acc)
    return offs


def rms_norm(x, g):
    xf = x.astype(jnp.float32)
    y = xf * lax.rsqrt(jnp.mean(xf * xf, axis=-1, keepdims=True) + NORM_EPS)
    return (y * g.astype(jnp.float32)).astype(x.dtype)


def masked_softmax(logits, mask):
    p = jax.nn.softmax(jnp.where(mask, logits, NEG), axis=-1)
    return jnp.where(mask, p, 0.0)


def rel_bucket(rel):
    n = jnp.maximum(rel, 0)
    exact = REL_BUCKETS // 2
    nf = jnp.maximum(n, 1).astype(jnp.float32)
    large = exact + (jnp.log(nf / exact) / math.log(REL_MAX_DIST / exact) * (REL_BUCKETS - exact)).astype(jnp.int32)
    large = jnp.minimum(large, REL_BUCKETS - 1)
    return jnp.where(n < exact, n, large)


def compress_blocks(x, pe, w1, b1, w2):
    B, S, G, dk = x.shape
    n_c = (S - CMP_LEN) // CMP_STRIDE + 1
    idx = np.arange(n_c, dtype=np.int32)[:, None] * CMP_STRIDE + np.arange(CMP_LEN, dtype=np.int32)[None, :]
    blk = x[:, idx] + pe[:, None, :]
    flat = blk.transpose(0, 1, 3, 2, 4).reshape(B, n_c, G, CMP_LEN * dk)
    return jax.nn.gelu(flat @ w1 + b1) @ w2


def nsa_attention(q, kc, vc, ks, vs, kw, vw, gates, tab):
    B, S, G, hg, dk = q.shape
    n_c = kc.shape[1]
    n_s = S // SLC_LEN
    n_top = min(SLC_TOPN, n_s)
    scale = dk ** -0.5
    f32 = jnp.float32
    c_start = np.arange(n_c, dtype=np.int32) * CMP_STRIDE
    c_last = c_start + (CMP_LEN - 1)
    s_start = np.arange(n_s, dtype=np.int32) * SLC_LEN
    overlap = jnp.asarray(((c_start[:, None] < s_start[None, :] + SLC_LEN) &
                           (c_start[:, None] + CMP_LEN > s_start[None, :])).astype(np.float32))
    ks_blk = ks.reshape(B, n_s, SLC_LEN, G, dk).transpose(0, 3, 1, 2, 4)
    vs_blk = vs.reshape(B, n_s, SLC_LEN, G, dk).transpose(0, 3, 1, 2, 4)
    kw_pad = jnp.pad(kw, ((0, 0), (WINDOW, 0), (0, 0), (0, 0)))
    vw_pad = jnp.pad(vw, ((0, 0), (WINDOW, 0), (0, 0), (0, 0)))
    n_win = Q_BLOCK + WINDOW
    rel_w = jnp.arange(Q_BLOCK)[:, None] - (jnp.arange(n_win) - WINDOW)[None, :]
    in_band = (rel_w >= 0) & (rel_w < WINDOW)
    bias_w = tab[rel_bucket(rel_w)].reshape(Q_BLOCK, n_win, G, hg).transpose(0, 2, 3, 1)
    tab_g = tab.reshape(REL_BUCKETS, G, hg).transpose(1, 0, 2)
    g_idx = jnp.arange(G)[None, :, None, None]
    blk_ids = jnp.arange(n_s, dtype=jnp.int32)
    take = jax.vmap(jax.vmap(lambda blocks, ix: blocks[ix]))

    def one_block(i):
        t0 = i * Q_BLOCK
        tpos = t0 + jnp.arange(Q_BLOCK, dtype=jnp.int32)
        qb = lax.dynamic_slice_in_dim(q, t0, Q_BLOCK, axis=1)
        gb = lax.dynamic_slice_in_dim(gates, t0, Q_BLOCK, axis=1)
        rel_c = tpos[:, None] - c_last[None, :]
        bias_c = tab[rel_bucket(rel_c)].reshape(Q_BLOCK, n_c, G, hg).transpose(0, 2, 3, 1)
        s_c = jnp.einsum('btghd,bcgd->btghc', qb, kc).astype(f32) * scale + bias_c
        p_c = masked_softmax(s_c, (rel_c >= 0)[:, None, None, :])
        o_c = jnp.einsum('btghc,bcgd->btghd', p_c.astype(vc.dtype), vc)
        imp = jnp.einsum('btghc,cj->btgj', p_c, overlap)
        cur = tpos // SLC_LEN
        forced = (blk_ids[None, :] == 0) | (blk_ids[None, :] == cur[:, None]) | (blk_ids[None, :] == cur[:, None] - 1)
        visible = blk_ids[None, :] <= cur[:, None]
        imp = jnp.where(forced[None, :, None, :], 1e6, jnp.where(visible[None, :, None, :], imp, -1e6))
        sel = lax.top_k(imp, n_top)[1].transpose(0, 2, 1, 3)
        n_k = n_top * SLC_LEN
        k_sel = take(ks_blk, sel).reshape(B, G, Q_BLOCK, n_k, dk)
        v_sel = take(vs_blk, sel).reshape(B, G, Q_BLOCK, n_k, dk)
        pos_sel = (sel[..., None] * SLC_LEN + jnp.arange(SLC_LEN, dtype=jnp.int32)).reshape(B, G, Q_BLOCK, n_k)
        rel_s = tpos[None, None, :, None] - pos_sel
        bias_s = tab_g[g_idx, rel_bucket(rel_s)].transpose(0, 1, 2, 4, 3)
        qg = qb.transpose(0, 2, 1, 3, 4)
        s_s = jnp.einsum('bgthd,bgtnd->bgthn', qg, k_sel).astype(f32) * scale + bias_s
        p_s = masked_softmax(s_s, (rel_s >= 0)[:, :, :, None, :])
        o_s = jnp.einsum('bgthn,bgtnd->bgthd', p_s.astype(v_sel.dtype), v_sel).transpose(0, 2, 1, 3, 4)
        kwb = lax.dynamic_slice_in_dim(kw_pad, t0, n_win, axis=1)
        vwb = lax.dynamic_slice_in_dim(vw_pad, t0, n_win, axis=1)
        kpos = t0 - WINDOW + jnp.arange(n_win, dtype=jnp.int32)
        mask_w = in_band & (kpos >= 0)[None, :]
        s_w = jnp.einsum('btghd,bkgd->btghk', qb, kwb).astype(f32) * scale + bias_w
        p_w = masked_softmax(s_w, mask_w[:, None, None, :])
        o_w = jnp.einsum('btghk,bkgd->btghd', p_w.astype(vwb.dtype), vwb)
        o = gb[..., 0:1] * o_c + gb[..., 1:2] * o_s + gb[..., 2:3] * o_w
        return o.reshape(B, Q_BLOCK, G * hg * dk)

    out = lax.map(one_block, jnp.arange(S // Q_BLOCK, dtype=jnp.int32))
    return out.transpose(1, 0, 2, 3).reshape(B, S, G * hg * dk)


def dsa_attention(q, k, v, iq, ik, iw, tab):
    B, S, H, dk = q.shape
    n_keep = min(DSA_TOPK_MAX, S // 4)
    scale = dk ** -0.5
    idx_scale = IDX_DIM ** -0.5
    f32 = jnp.float32
    key_pos = jnp.arange(S, dtype=jnp.int32)
    take = jax.vmap(lambda rows, ix: rows[ix])

    def one_block(i):
        t0 = i * Q_BLOCK
        tpos = t0 + jnp.arange(Q_BLOCK, dtype=jnp.int32)
        qb = lax.dynamic_slice_in_dim(q, t0, Q_BLOCK, axis=1)
        iqb = lax.dynamic_slice_in_dim(iq, t0, Q_BLOCK, axis=1)
        iwb = lax.dynamic_slice_in_dim(iw, t0, Q_BLOCK, axis=1)
        act = jax.nn.relu(jnp.einsum('bthd,bsd->bths', iqb, ik).astype(f32) * idx_scale)
        score = jnp.einsum('bths,bth->bts', act, iwb.astype(f32))
        causal = tpos[:, None] >= key_pos[None, :]
        score = jnp.where(causal[None], score, NEG)
        sel = lax.top_k(score, n_keep)[1]
        k_sel = take(k, sel)
        v_sel = take(v, sel)
        rel = tpos[None, :, None] - sel
        bias = tab[rel_bucket(rel)].transpose(0, 1, 3, 2)
        s = jnp.einsum('bthd,btnd->bthn', qb, k_sel).astype(f32) * scale + bias
        p = masked_softmax(s, (rel >= 0)[:, :, None, :])
        o = jnp.einsum('bthn,btnd->bthd', p.astype(v_sel.dtype), v_sel)
        return o.reshape(B, Q_BLOCK, H * dk)

    out = lax.map(one_block, jnp.arange(S // Q_BLOCK, dtype=jnp.int32))
    return out.transpose(1, 0, 2, 3).reshape(B, S, H * dk)


def clamped_swiglu(hu):
    glu, lin = hu[..., ::2], hu[..., 1::2]
    glu = jnp.minimum(glu, SWIGLU_LIMIT)
    lin = jnp.clip(lin, -SWIGLU_LIMIT, SWIGLU_LIMIT)
    return glu * jax.nn.sigmoid(SWIGLU_ALPHA * glu) * (lin + 1.0)


def moe_ffn(h, w_router, b_router, w_gate_up, b_gate_up, w_down, b_down):
    B, S, D = h.shape
    N = B * S
    NK = N * MOE_TOPK
    R = MOE_ROW_BLOCK
    xf = h.reshape(N, D)
    logits = (xf @ w_router).astype(jnp.float32) + b_router.astype(jnp.float32)
    top_val, top_e = lax.top_k(logits, MOE_TOPK)
    gate = jax.nn.softmax(top_val, axis=-1)
    flat_e = top_e.reshape(-1)
    flat_tok = jnp.repeat(jnp.arange(N, dtype=jnp.int32), MOE_TOPK)
    order = jnp.argsort(flat_e)
    se, st, sg = flat_e[order], flat_tok[order], gate.reshape(-1)[order]
    counts = jnp.bincount(flat_e, length=N_EXPERTS)
    padded = (counts + R - 1) // R * R
    pad_end = jnp.cumsum(padded)
    pad_start = pad_end - padded
    start = jnp.cumsum(counts) - counts
    dest = pad_start[se] + (jnp.arange(NK, dtype=jnp.int32) - start[se])
    n_rows = (NK + R - 1) // R * R + N_EXPERTS * R
    n_blocks = n_rows // R
    row_tok = jnp.full((n_rows,), N, jnp.int32).at[dest].set(st)
    row_gate = jnp.zeros((n_rows,), jnp.float32).at[dest].set(sg)
    blk_e = jnp.minimum(jnp.searchsorted(pad_end, jnp.arange(n_blocks, dtype=jnp.int32) * R, side='right'), N_EXPERTS - 1)
    x_pad = jnp.concatenate([xf, jnp.zeros((1, D), xf.dtype)], axis=0)

    def run_block(args):
        tok, g, e = args
        xb = x_pad[tok]
        hu = xb @ w_gate_up[e] + b_gate_up[e]
        y = clamped_swiglu(hu) @ w_down[e] + b_down[e]
        return y * g[:, None].astype(y.dtype)

    ys = lax.map(run_block, (row_tok.reshape(n_blocks, R), row_gate.reshape(n_blocks, R), blk_e))
    out = jnp.zeros((N + 1, D), ys.dtype).at[row_tok].add(ys.reshape(n_rows, D))
    return out[:N].reshape(B, S, D)


def hybrid_layer(x, attn_norm, w_in, nsa_q_norm, nsa_k_norm, cmp_k_pe, cmp_k_w1, cmp_k_b1, cmp_k_w2,
                 cmp_v_pe, cmp_v_w1, cmp_v_b1, cmp_v_w2, dsa_kv_norm, dsa_w_uk, dsa_w_uv, dsa_q_norm,
                 dsa_k_norm, w_branch_a, w_branch_b, w_out, rel_bias, ffn_norm, w_router, b_router,
                 w_gate_up, b_gate_up, w_down, b_down):
    B, S, _ = x.shape
    G, hg, dk = NSA_KV_HEADS, NSA_GROUP, HEAD_DIM
    h = rms_norm(x, attn_norm)
    (a_q, c_k, c_v, s_k, s_v, w_k, w_v, a_g, b_q, b_ckv, i_q, i_k, i_w, g_a, g_b) = jnp.split(h @ w_in, _split_offsets(), axis=-1)
    kv_shape = (B, S, G, dk)
    q_a = rms_norm(a_q.reshape(B, S, NSA_HEADS, dk), nsa_q_norm).reshape(B, S, G, hg, dk)
    kc = rms_norm(compress_blocks(c_k.reshape(kv_shape), cmp_k_pe, cmp_k_w1, cmp_k_b1, cmp_k_w2), nsa_k_norm)
    vc = compress_blocks(c_v.reshape(kv_shape), cmp_v_pe, cmp_v_w1, cmp_v_b1, cmp_v_w2)
    ks = rms_norm(s_k.reshape(kv_shape), nsa_k_norm)
    kw = rms_norm(w_k.reshape(kv_shape), nsa_k_norm)
    branch_gates = jax.nn.sigmoid(a_g).reshape(B, S, G, hg, 3)
    o_a = nsa_attention(q_a, kc, vc, ks, s_v.reshape(kv_shape), kw, w_v.reshape(kv_shape), branch_gates, rel_bias[:, :NSA_HEADS])
    q_b = rms_norm(b_q.reshape(B, S, DSA_HEADS, dk), dsa_q_norm)
    ckv = rms_norm(b_ckv, dsa_kv_norm)
    k_b = rms_norm(ckv @ dsa_w_uk, dsa_k_norm)
    v_b = ckv @ dsa_w_uv
    o_b = dsa_attention(q_b, k_b, v_b, i_q.reshape(B, S, IDX_HEADS, IDX_DIM), i_k, i_w * IDX_HEADS ** -0.5, rel_bias[:, NSA_HEADS:])
    merged = jax.nn.sigmoid(g_a) * (o_a @ w_branch_a) + jax.nn.sigmoid(g_b) * (o_b @ w_branch_b)
    x = x + merged @ w_out
    return x + moe_ffn(rms_norm(x, ffn_norm), w_router, b_router, w_gate_up, b_gate_up, w_down, b_down)


def setup_inputs(seed: int = 0) -> dict:
    key = jax.random.key(seed)
    ks = jax.random.split(key, 32)
    L, D, dk = DEPTH, D_MODEL, HEAD_DIM
    d_in = sum(_in_widths())
    f32 = jnp.float32

    def nrm(k, shape, scale):
        return jax.random.normal(k, shape, f32) * scale

    def gain(k, n):
        return 1.0 + 0.02 * jax.random.normal(k, (L, n), f32)

    return {
        'x': jax.random.normal(ks[0], (BATCH, SEQ, D), f32),
        'attn_norm': gain(ks[1], D),
        'w_in': nrm(ks[2], (L, D, d_in), D ** -0.5),
        'nsa_q_norm': gain(ks[3], dk),
        'nsa_k_norm': gain(ks[4], dk),
        'cmp_k_pe': nrm(ks[5], (L, CMP_LEN, dk), 0.1),
        'cmp_k_w1': nrm(ks[6], (L, CMP_LEN * dk, CMP_HID), (CMP_LEN * dk) ** -0.5),
        'cmp_k_b1': nrm(ks[7], (L, CMP_HID), 0.01),
        'cmp_k_w2': nrm(ks[8], (L, CMP_HID, dk), CMP_HID ** -0.5),
        'cmp_v_pe': nrm(ks[9], (L, CMP_LEN, dk), 0.1),
        'cmp_v_w1': nrm(ks[10], (L, CMP_LEN * dk, CMP_HID), (CMP_LEN * dk) ** -0.5),
        'cmp_v_b1': nrm(ks[11], (L, CMP_HID), 0.01),
        'cmp_v_w2': nrm(ks[12], (L, CMP_HID, dk), CMP_HID ** -0.5),
        'dsa_kv_norm': gain(ks[13], DSA_KV_RANK),
        'dsa_w_uk': nrm(ks[14], (L, DSA_KV_RANK, dk), DSA_KV_RANK ** -0.5),
        'dsa_w_uv': nrm(ks[15], (L, DSA_KV_RANK, dk), DSA_KV_RANK ** -0.5),
        'dsa_q_norm': gain(ks[16], dk),
        'dsa_k_norm': gain(ks[17], dk),
        'w_branch_a': nrm(ks[18], (L, NSA_HEADS * dk, D), (NSA_HEADS * dk) ** -0.5),
        'w_branch_b': nrm(ks[19], (L, DSA_HEADS * dk, D), (DSA_HEADS * dk) ** -0.5),
        'w_out': nrm(ks[20], (L, D, D), D ** -0.5),
        'rel_bias': nrm(ks[21], (REL_BUCKETS, N_BIAS_HEADS), 0.2),
        'ffn_norm': gain(ks[22], D),
        'w_router': nrm(ks[23], (L, D, N_EXPERTS), D ** -0.5),
        'b_router': nrm(ks[24], (L, N_EXPERTS), 0.01),
        'w_gate_up': nrm(ks[25], (L, N_EXPERTS, D, 2 * D_EXPERT), D ** -0.5),
        'b_gate_up': nrm(ks[26], (L, N_EXPERTS, 2 * D_EXPERT), 0.01),
        'w_down': nrm(ks[27], (L, N_EXPERTS, D_EXPERT, D), D_EXPERT ** -0.5),
        'b_down': nrm(ks[28], (L, N_EXPERTS, D), 0.01),
    }


def reference(x, attn_norm, w_in, nsa_q_norm, nsa_k_norm, cmp_k_pe, cmp_k_w1, cmp_k_b1, cmp_k_w2,
              cmp_v_pe, cmp_v_w1, cmp_v_b1, cmp_v_w2, dsa_kv_norm, dsa_w_uk, dsa_w_uv, dsa_q_norm,
              dsa_k_norm, w_branch_a, w_branch_b, w_out, rel_bias, ffn_norm, w_router, b_router,
              w_gate_up, b_gate_up, w_down, b_down):
    for l in range(DEPTH):
        x = hybrid_layer(x, attn_norm[l], w_in[l], nsa_q_norm[l], nsa_k_norm[l], cmp_k_pe[l], cmp_k_w1[l],
                         cmp_k_b1[l], cmp_k_w2[l], cmp_v_pe[l], cmp_v_w1[l], cmp_v_b1[l], cmp_v_w2[l],
                         dsa_kv_norm[l], dsa_w_uk[l], dsa_w_uv[l], dsa_q_norm[l], dsa_k_norm[l],
                         w_branch_a[l], w_branch_b[l], w_out[l], rel_bias, ffn_norm[l], w_router[l],
                         b_router[l], w_gate_up[l], b_gate_up[l], w_down[l], b_down[l])
    return x
```

```cpp
#define MK_ONE_LAUNCH 1
#include <hip/hip_runtime.h>
#include <cstdio>
#include <cstdint>

#define GAS __attribute__((address_space(1)))
#define LAS __attribute__((address_space(3)))
typedef unsigned short bf16;
typedef unsigned v4u __attribute__((ext_vector_type(4)));
typedef unsigned v2u __attribute__((ext_vector_type(2)));
typedef float f32x4 __attribute__((ext_vector_type(4)));
typedef float f32x16 __attribute__((ext_vector_type(16)));
typedef short bf16x8 __attribute__((ext_vector_type(8)));
typedef short bf16x4 __attribute__((ext_vector_type(4)));
typedef short v4i16_t __attribute__((ext_vector_type(4)));
typedef GAS unsigned gu32;

constexpr int NB = 8, SEQ = 8192, DM = 1024, NTOK = NB * SEQ;
constexpr int DIN = 4576, NPIN = 4608;
constexpr int NEXP = 32, TOPK = 4, DEXP = 1024;
constexpr int MAXTILES = NTOK * TOPK / 256 + NEXP;
constexpr float NORM_EPS = 1e-6f;
constexpr float LOG2E = 1.4426950408889634f;
constexpr float QSCALE = 0.125f * LOG2E;
constexpr int NCMP = 511, NCMPP = 512;
constexpr int NWAVES = 8;

constexpr size_t MiB = 1u << 20;
constexpr size_t WS_CTL = 0, CTL_ZERO_BYTES = 1 * MiB;
constexpr size_t WS_BIASLUT = 1 * MiB;
constexpr size_t WS_TILEE = 1 * MiB + 64 * 1024;
constexpr size_t WS_WRP = 1 * MiB + 256 * 1024;
constexpr size_t WS_GAINS = 1 * MiB + 512 * 1024;
constexpr size_t WS_CW1K = 2 * MiB, WS_CW1V = 2 * MiB + 512 * 1024;
constexpr size_t WS_CW2K = 3 * MiB, WS_CW2V = 3 * MiB + 16 * 1024;
constexpr size_t WS_WUK = 3 * MiB + 32 * 1024, WS_WUV = 3 * MiB + 48 * 1024;
constexpr size_t WS_CB1K = 3 * MiB + 64 * 1024, WS_CB1V = 3 * MiB + 65 * 1024;
constexpr size_t WS_KC = 4 * MiB, WS_VC = 5 * MiB;
constexpr size_t WS_TOKE = 6 * MiB, WS_TOKG = 7 * MiB, WS_TOKP = 8 * MiB;
constexpr size_t WS_ROWTOK = 9 * MiB, WS_ROWGATE = 10 * MiB + 512 * 1024;
constexpr size_t WS_IW = 12 * MiB, WS_AG = 14 * MiB;
constexpr size_t WS_WIN = 20 * MiB;
constexpr size_t WS_WA = 29 * MiB, WS_WB = 30 * MiB, WS_WO = 31 * MiB;
constexpr size_t WS_W1T = 33 * MiB, WS_W2T = 161 * MiB;
constexpr size_t WS_XN = 225 * MiB;
constexpr size_t WS_QA = 353 * MiB, WS_QB = 417 * MiB, WS_IQ = 481 * MiB, WS_GA = 545 * MiB, WS_GB = 673 * MiB;
constexpr size_t WS_SK = 801 * MiB, WS_WK = 817 * MiB, WS_CK = 833 * MiB, WS_CV = 849 * MiB, WS_SV = 865 * MiB, WS_WV = 881 * MiB;
constexpr size_t WS_CKV = 897 * MiB, WS_IK = 913 * MiB, WS_KB = 921 * MiB, WS_VB = 929 * MiB, WS_END = 960 * MiB;
constexpr size_t WS_YX = 940 * MiB;
constexpr size_t WS_ACT = 353 * MiB;
static_assert(WS_ACT + (size_t)MAXTILES * 256 * 1024 * 2 <= WS_END, "ACT overlay");
constexpr int CW_TMO = 0, CW_CODE = 1;
constexpr int CW_BAR = 4096;
constexpr int CW_CNT = 16384;

constexpr int RING_OFF = 0, RING_BYTES = 131072;
constexpr int LDSCTL_OFF = RING_BYTES, MISC_OFF = LDSCTL_OFF + 320;
constexpr int LDS_BYTES = 147456;

#define RLX_AGENT __ATOMIC_RELAXED, __HIP_MEMORY_SCOPE_AGENT
#define LDS_WAIT() asm volatile("s_waitcnt lgkmcnt(0)" ::: "memory")
#define VM_WAIT() asm volatile("s_waitcnt vmcnt(0)" ::: "memory")
__device__ __forceinline__ unsigned f2bf(float f) { unsigned u = __builtin_bit_cast(unsigned, f); return (u + 0x7fffu + ((u >> 16) & 1u)) >> 16; }
__device__ __forceinline__ unsigned pk2(float lo, float hi) { return f2bf(lo) | (f2bf(hi) << 16); }
__device__ __forceinline__ float bf2f(unsigned short h) { return __builtin_bit_cast(float, (unsigned)h << 16); }
__device__ __forceinline__ float bflo(unsigned w) { return __builtin_bit_cast(float, w << 16); }
__device__ __forceinline__ float bfhi(unsigned w) { return __builtin_bit_cast(float, w & 0xffff0000u); }
__device__ __forceinline__ float fast_exp2(float x) { return __builtin_amdgcn_exp2f(x); }
__device__ __forceinline__ float fast_rcp(float x) { return __builtin_amdgcn_rcpf(x); }
__device__ __forceinline__ float sigmoidf_(float x) { return fast_rcp(1.f + fast_exp2(-x * LOG2E)); }

__device__ const unsigned char REL_BUCKET[128] = {0,1,2,3,4,5,6,7,8,9,10,11,12,13,14,15,16,16,16,17,17,18,18,18,19,19,19,20,20,20,20,21,21,21,21,22,22,22,22,22,23,23,23,23,23,23,24,24,24,24,24,24,25,25,25,25,25,25,25,26,26,26,26,26,26,26,26,27,27,27,27,27,27,27,27,27,27,28,28,28,28,28,28,28,28,28,28,29,29,29,29,29,29,29,29,29,29,29,29,30,30,30,30,30,30,30,30,30,30,30,30,30,30,31,31,31,31,31,31,31,31,31,31,31,31,31,31,31};
namespace pg8 {
#define PG8_LAS __attribute__((address_space(3)))
typedef unsigned short bf16_t;
typedef short bf16x8 __attribute__((ext_vector_type(8)));
typedef float f32x4 __attribute__((ext_vector_type(4)));
typedef unsigned u32x4 __attribute__((ext_vector_type(4)));
typedef unsigned u32x2 __attribute__((ext_vector_type(2)));
constexpr int BM = 256, BK = 64, HALF = 128, HTB = HALF * BK * 2  , STAGE_BYTES = 8 * HTB, NXCD = 8, WGM = 8;

__host__ __device__ __forceinline__ int lds_byte(int r, int c) { const int st = (r >> 4) * 2 + (c >> 5), rr = r & 15, cc = c & 31, ob = rr * 64 + cc * 2; return st * 1024 + (ob ^ (((ob >> 9) & 1) << 5)); }
__host__ __device__ __forceinline__ void stage_rc(int b, int& R, int& C) { const int st = b / 1024, sb = b % 1024, swz = sb ^ (((sb >> 9) & 1) << 5); R = (st >> 1) * 16 + swz / 64; C = (st & 1) * 32 + (swz % 64) / 2; }
__host__ __device__ __forceinline__ int perm32(int rho) { const int n = rho >> 4, i = rho & 15; return 8 * (i >> 2) + 4 * n + (i & 3); }

struct Unit { int pm, pn, pb; };
struct Gemm { const bf16_t* A; const bf16_t* Bt; int M, N, K; };

struct StaticOrder {
    int nM, nN, nwg, G, c;
    __host__ __device__ void init(int M, int N, int G_, int c_) { nM = M / BM; nN = N / BM; nwg = nM * nN; G = G_; c = c_; }
    __host__ __device__ bool next(int i, Unit& u) const {
        const long L = (long)i * G + c; if (L >= nwg) return false;
        int wgid = (int)L; { const int q = nwg / NXCD, r = nwg % NXCD, xcd = wgid % NXCD, off = wgid / NXCD; wgid = (xcd < r ? xcd * (q + 1) : r * (q + 1) + (xcd - r) * q) + off; }
        const int nig = WGM * nN, gid = wgid / nig, fm = gid * WGM, gsz = (nM - fm) < WGM ? (nM - fm) : WGM;
        u.pm = fm + ((wgid % nig) % gsz); u.pn = (wgid % nig) / gsz; u.pb = u.pn; return true;
    }
};
struct MoeOrder {
    int nM, nN, nwg, G, c; const PG8_LAS int* tile_e;
    __device__ void init(int T, int nN_, int G_, int c_, const PG8_LAS int* te) { nM = T; nN = nN_; nwg = nM * nN; G = G_; c = c_; tile_e = te; }
    __device__ bool next(int i, Unit& u) const {
        const long L = (long)i * G + c; if (L >= nwg) return false;
        int wgid = (int)L; { const int q = nwg / NXCD, r = nwg % NXCD, xcd = wgid % NXCD, off = wgid / NXCD; wgid = (xcd < r ? xcd * (q + 1) : r * (q + 1) + (xcd - r) * q) + off; }
        const int nig = WGM * nN, gid = wgid / nig, fm = gid * WGM, gsz = (nM - fm) < WGM ? (nM - fm) : WGM;
        u.pm = fm + ((wgid % nig) % gsz); u.pn = (wgid % nig) / gsz;
        const int e = __builtin_amdgcn_readfirstlane(tile_e[u.pm]); u.pb = e * nN + u.pn; return true;
    }
};

__device__ __forceinline__ void glds16_s(const void* sbase, unsigned voff, unsigned lds_dst) { unsigned keep;
    asm volatile("s_mov_b32 %0, m0\n\ts_mov_b32 m0, %3\n\ts_nop 0\n\tglobal_load_lds_dwordx4 %2, %1\n\ts_mov_b32 m0, %0" : "=&s"(keep) : "s"(sbase), "v"(voff), "s"(lds_dst) : "memory"); }
struct MoeRowOrder {
    int nM, nN, G, c; const PG8_LAS int* tile_e;
    __device__ void init(int T, int nN_, int G_, int c_, const PG8_LAS int* te) { nM = T; nN = nN_; G = G_; c = c_; tile_e = te; }
    __device__ bool next(int i, Unit& u) const {
        const int rfull = nM / G, nfull = rfull * nN;
        if (i < nfull) { const int round = i / nN; u.pn = i - round * nN; u.pm = round * G + c; }
        else { const int L = c + G * (i - nfull); if (L >= (nM - rfull * G) * nN) return false; u.pm = rfull * G + L / nN; u.pn = L % nN; }
        const int e = __builtin_amdgcn_readfirstlane(tile_e[u.pm]); u.pb = e * nN + u.pn; return true;
    }
};
__device__ __forceinline__ unsigned cvt_pk_bf16(float lo, float hi) { unsigned r; asm volatile("v_cvt_pk_bf16_f32 %0, %1, %2" : "=v"(r) : "v"(lo), "v"(hi)); return r; }

template <class Epi, class Sched, int KC, bool ALIGN_EPI = false, bool GATHER = false>
__device__ __forceinline__ void gemm_phase(PG8_LAS unsigned char* lds, const Gemm g, const Sched& S, const Epi& E, const int* rowtab = nullptr) {
    int tid_ = threadIdx.x; asm volatile("" : "+v"(tid_));
    const int tid = tid_, wid = __builtin_amdgcn_readfirstlane(tid >> 6), lane = tid & 63, wr = wid >> 2, wc = wid & 3, fr = lane & 15, fq = lane >> 4;
    constexpr int K = KC, nt = K / BK; static_assert(KC % 128 == 0 && KC >= 256, "K");
    unsigned voffA[2], voffB[2];
#pragma unroll
    for (int i = 0; i < 2; ++i) { int R, C; stage_rc(tid * 16 + i * 8192, R, C); const int Rb = Epi::PERM ? ((R & ~31) + perm32(R & 31)) : R;
        voffA[i] = (unsigned)(R * K + C) * 2u; voffB[i] = (unsigned)(Rb * K + C) * 2u; }
    const size_t kstep = (size_t)(BK * 2);
    const size_t hstep = (size_t)HALF * K * 2;
    const size_t tstep = 2 * hstep;
    const unsigned ldsw = (unsigned)wid * 1024u; const unsigned ldsu = (unsigned)(size_t)lds;
    const int aoff = lds_byte(wr * 64 + fr, fq * 8), boff = lds_byte(wc * 32 + fr, fq * 8);
#define PG8_SA(b, h) (((b) * 2 + (h)) * HTB)
#define PG8_SB(b, h) ((4 + (b) * 2 + (h)) * HTB)
#define PG8_STAGE(bufoff, gbase, voff) do { _Pragma("unroll") for (int _i = 0; _i < 2; ++_i) \
        glds16_s((const void*)((const char*)(gbase)), (voff)[_i], ldsu + (unsigned)(bufoff) + ldsw + (unsigned)(_i * 8192)); } while (0)
#define PG8_STAGE_A(bufoff, h, pA, kb, NEXT) do { if constexpr (GATHER) { PG8_STAGE(bufoff, (const char*)g.A + (kb), gC[h]); } else { PG8_STAGE(bufoff, (pA) + (size_t)(h) * hstep + (kb), voffA); } } while (0)
#define PG8_LDA(dst, b, h) do { _Pragma("unroll") for (int m = 0; m < 4; ++m) _Pragma("unroll") for (int k = 0; k < 2; ++k) dst[m][k] = *(const PG8_LAS bf16x8*)(lds + PG8_SA(b, h) + aoff + m * 2048 + k * 1024); } while (0)
#define PG8_LDB(dst, b, h) do { _Pragma("unroll") for (int n = 0; n < 2; ++n) _Pragma("unroll") for (int k = 0; k < 2; ++k) dst[n][k] = *(const PG8_LAS bf16x8*)(lds + PG8_SB(b, h) + boff + n * 2048 + k * 1024); } while (0)
#define PG8_MMA(ai, bj, At, Bt) do { __builtin_amdgcn_s_setprio(1); _Pragma("unroll") for (int m = 0; m < 4; ++m) _Pragma("unroll") for (int n = 0; n < 2; ++n) _Pragma("unroll") for (int k = 0; k < 2; ++k) \
        acc[ai][bj][m][n] = __builtin_amdgcn_mfma_f32_16x16x32_bf16(Bt[n][k], At[m][k], acc[ai][bj][m][n], 0, 0, 0); __builtin_amdgcn_s_setprio(0); } while (0)
#define PG8_WAIT_V(n) asm volatile("s_waitcnt vmcnt(" #n ")" ::: "memory")
#define PG8_WAIT_L(n) asm volatile("s_waitcnt lgkmcnt(" #n ")" ::: "memory")
#define PG8_BAR __builtin_amdgcn_s_barrier()
#define PG8_SCHED __builtin_amdgcn_sched_barrier(0)
    Unit cur, nxt; int ui = 0;
    if (!S.next(0, cur)) return;
    f32x4 acc[2][2][4][2];
#pragma unroll
    for (int a = 0; a < 2; ++a)
#pragma unroll
        for (int b = 0; b < 2; ++b)
#pragma unroll
            for (int m = 0; m < 4; ++m)
#pragma unroll
                for (int n = 0; n < 2; ++n) acc[a][b][m][n] = (f32x4){0.f, 0.f, 0.f, 0.f};
    bf16x8 At[4][2], B0[2][2], B1[2][2];
    unsigned gC[2][2] = {{0u, 0u}, {0u, 0u}}; PG8_LAS unsigned* park = (PG8_LAS unsigned*)(lds + STAGE_BYTES + 1024);
    if constexpr (GATHER) {
#pragma unroll
        for (int h = 0; h < 2; ++h)
#pragma unroll
            for (int i = 0; i < 2; ++i) { int R, C; stage_rc(tid * 16 + i * 8192, R, C); int t = rowtab[cur.pm * BM + h * HALF + R]; t = t < 0 ? 0 : t; gC[h][i] = (unsigned)t * (unsigned)(K * 2) + (unsigned)(C * 2); }
    }
    int gR[2][2] = {{0, 0}, {0, 0}};
    if constexpr (GATHER) { Unit n1; const int pm1 = S.next(1, n1) ? n1.pm : cur.pm;
#pragma unroll
        for (int h = 0; h < 2; ++h)
#pragma unroll
            for (int i = 0; i < 2; ++i) { int R, C; stage_rc(tid * 16 + i * 8192, R, C); gR[h][i] = rowtab[pm1 * BM + h * HALF + R]; } }
    const char* cA = (const char*)g.A + (GATHER ? (size_t)0 : (size_t)cur.pm * tstep); const char* cB = (const char*)g.Bt + (size_t)cur.pb * tstep;
    PG8_STAGE(PG8_SB(0, 0), cB, voffB); PG8_STAGE(PG8_SB(0, 1), cB + hstep, voffB); PG8_STAGE_A(PG8_SA(0, 0), 0, cA, (size_t)0, false); PG8_STAGE_A(PG8_SA(0, 1), 1, cA, (size_t)0, false);
    if (wr == 1) PG8_BAR;
    PG8_WAIT_V(2); PG8_BAR;
    PG8_STAGE(PG8_SB(1, 0), cB + kstep, voffB); PG8_STAGE_A(PG8_SA(1, 0), 0, cA, kstep, false); PG8_STAGE(PG8_SB(1, 1), cB + hstep + kstep, voffB);
    PG8_WAIT_V(6); PG8_BAR;
    for (;;) {
        const bool has_next = S.next(ui + 1, nxt);
        if constexpr (GATHER) {
#pragma unroll
            for (int h = 0; h < 2; ++h)
#pragma unroll
                for (int i = 0; i < 2; ++i) { int R, C; stage_rc(tid * 16 + i * 8192, R, C); int t = gR[h][i]; t = t < 0 ? 0 : t; park[(h * 2 + i) * 512 + tid] = (unsigned)t * (unsigned)(K * 2) + (unsigned)(C * 2); }
            Unit n2; const bool has2 = has_next && S.next(ui + 2, n2); const int pm2 = has2 ? n2.pm : (has_next ? nxt.pm : cur.pm);
#pragma unroll
            for (int h = 0; h < 2; ++h)
#pragma unroll
                for (int i = 0; i < 2; ++i) { int R, C; stage_rc(tid * 16 + i * 8192, R, C); gR[h][i] = rowtab[pm2 * BM + h * HALF + R]; }
        }
        const char* nA = GATHER ? cA : (has_next ? (const char*)g.A + (size_t)nxt.pm * tstep : cA); const char* nB = has_next ? (const char*)g.Bt + (size_t)nxt.pb * tstep : cB;
#define PG8_ITER(LASTF) do { \
            const size_t k1 = (size_t)(t + 1) * kstep; \
            const size_t k2 = (LASTF) ? (size_t)0 : (size_t)(t + 2) * kstep; \
            const size_t k3 = k2 + kstep; \
            const char* a2 = (LASTF) ? nA : cA; const char* b2 = ((LASTF) ? nB : cB) + k2; const char* b3 = b2 + kstep; \
            PG8_LDB(B0, 0, 0); PG8_LDB(B1, 0, 1); PG8_SCHED; PG8_LDA(At, 0, 0); PG8_STAGE_A(PG8_SA(1, 1), 1, cA, k1, false); \
            if constexpr (GATHER && (LASTF)) { _Pragma("unroll") for (int _h = 0; _h < 2; ++_h) _Pragma("unroll") for (int _i = 0; _i < 2; ++_i) gC[_h][_i] = park[(_h * 2 + _i) * 512 + tid]; } \
            PG8_WAIT_V(8); PG8_WAIT_L(0); PG8_BAR; PG8_MMA(0, 0, At, B0); PG8_MMA(0, 1, At, B1); PG8_BAR; PG8_SCHED; \
            PG8_LDA(At, 0, 1); PG8_STAGE(PG8_SB(0, 0), b2, voffB); PG8_STAGE(PG8_SB(0, 1), b2 + hstep, voffB); PG8_STAGE_A(PG8_SA(0, 0), 0, a2, k2, LASTF); \
            PG8_WAIT_V(8); PG8_WAIT_L(0); PG8_BAR; PG8_MMA(1, 0, At, B0); PG8_MMA(1, 1, At, B1); PG8_BAR; PG8_SCHED; \
            PG8_LDB(B0, 1, 0); PG8_LDB(B1, 1, 1); PG8_SCHED; PG8_LDA(At, 1, 0); PG8_STAGE_A(PG8_SA(0, 1), 1, a2, k2, LASTF); \
            PG8_WAIT_V(8); PG8_WAIT_L(0); PG8_BAR; PG8_MMA(0, 0, At, B0); PG8_MMA(0, 1, At, B1); PG8_BAR; PG8_SCHED; \
            PG8_LDA(At, 1, 1); PG8_STAGE(PG8_SB(1, 0), b3, voffB); PG8_STAGE(PG8_SB(1, 1), b3 + hstep, voffB); PG8_STAGE_A(PG8_SA(1, 0), 0, a2, k3, LASTF); \
            PG8_WAIT_V(8); PG8_WAIT_L(0); PG8_BAR; PG8_MMA(1, 0, At, B0); PG8_MMA(1, 1, At, B1); PG8_BAR; PG8_SCHED; } while (0)
        { int t = 0;
          for (; t < nt - 2; t += 2) PG8_ITER(false);
          PG8_ITER(true); }
#undef PG8_ITER
        if constexpr (ALIGN_EPI) { if (wr == 0) PG8_BAR; }
        E(acc, cur, wr, wc, fr, fq);
        if (!has_next) break;
#pragma unroll
        for (int a = 0; a < 2; ++a)
#pragma unroll
            for (int b = 0; b < 2; ++b)
#pragma unroll
                for (int m = 0; m < 4; ++m)
#pragma unroll
                    for (int n = 0; n < 2; ++n) acc[a][b][m][n] = (f32x4){0.f, 0.f, 0.f, 0.f};
        cur = nxt; cA = nA; cB = nB; ++ui;
        if constexpr (ALIGN_EPI) { if (wr == 1) PG8_BAR; }
    }
    PG8_WAIT_V(0);
    if constexpr (!ALIGN_EPI) { if (wr == 0) PG8_BAR; }
    PG8_BAR;
#undef PG8_SA
#undef PG8_SB
#undef PG8_STAGE
#undef PG8_STAGE_A
#undef PG8_LDA
#undef PG8_LDB
#undef PG8_MMA
#undef PG8_WAIT_V
#undef PG8_WAIT_L
#undef PG8_BAR
#undef PG8_SCHED
}
}

#define XB_TMO      128
#define XB_XCNT(j)  (256  + 64 * (j))
#define XB_XSUB(j)  (1280 + 64 * (j))
#define XB_XGEN(j)  (2304 + 64 * (j))
#define XB_TOP      3328
#define XB_TOPGEN   3392
#define XCD_BAR_WORDS 3456
#define XB_SPIN_CAP (1u << 18)

__device__ __forceinline__ unsigned xb_ld(unsigned* p)              { return __hip_atomic_load(p, __ATOMIC_RELAXED, __HIP_MEMORY_SCOPE_AGENT); }
__device__ __forceinline__ unsigned xb_add(unsigned* p, unsigned v) { return __hip_atomic_fetch_add(p, v, __ATOMIC_RELAXED, __HIP_MEMORY_SCOPE_AGENT); }
__device__ __forceinline__ unsigned xb_xcc_id() { return (unsigned)__builtin_amdgcn_s_getreg((3 << 11) | 20) & 0xFu; }
#define XB_SPIN(cond, bar) do { unsigned _sp = 0; while (cond) { __builtin_amdgcn_s_sleep(1); \
    if ((++_sp & 255u) == 0u) { if (xb_ld(&(bar)[XB_TMO])) break; if (_sp > XB_SPIN_CAP) { atomicAdd(&(bar)[XB_TMO], 1u); break; } } } } while (0)

struct XcdBarrier {
    unsigned* bar; unsigned x;
    volatile LAS unsigned* st;
};
__device__ __forceinline__ XcdBarrier xcd_barrier_post(unsigned* bar, volatile LAS unsigned* st) {
    XcdBarrier b; b.bar = bar; b.x = xb_xcc_id(); b.st = st;
    if (threadIdx.x == 0) (void)xb_add(&bar[XB_XCNT(b.x)], 1u);
    return b;
}
__device__ __forceinline__ void xcd_barrier_complete(unsigned* bar, unsigned x, unsigned& nloc, unsigned& nx) {
    const unsigned G = gridDim.x * gridDim.y * gridDim.z;
    unsigned sum, cnt, mine, sp = 0u;
    for (;;) {
        sum = 0u; cnt = 0u; mine = 0u;
#pragma unroll
        for (unsigned j = 0; j < 16; ++j) { const unsigned c = xb_ld(&bar[XB_XCNT(j)]); sum += c; cnt += (c > 0u) ? 1u : 0u; mine = (j == x) ? c : mine; }
        if (sum == G) break;
        __builtin_amdgcn_s_sleep(1);
        if ((++sp & 255u) == 0u) { if (xb_ld(&bar[XB_TMO])) break; if (sp > XB_SPIN_CAP) { atomicAdd(&bar[XB_TMO], 1u); break; } }
    }
    nloc = mine > 0u ? mine : 1u; nx = cnt > 0u ? cnt : 1u;
}
__device__ __forceinline__ void xcd_barrier(const XcdBarrier& b) {
    asm volatile("s_waitcnt vmcnt(0)" ::: "memory");
    __syncthreads();
    if (threadIdx.x == 0) {
        unsigned* bar = b.bar;
        __builtin_amdgcn_s_waitcnt(0);
        unsigned nloc = b.st[0], nx = b.st[1];
        if (nloc == 0u) { xcd_barrier_complete(bar, b.x, nloc, nx); b.st[0] = nloc; b.st[1] = nx; }
        const unsigned old = xb_add(&bar[XB_XSUB(b.x)], 1u);
        const unsigned gen = old / nloc;
        if (old + 1u == (gen + 1u) * nloc) {
            __builtin_amdgcn_fence(__ATOMIC_RELEASE, "agent");
            asm volatile("s_waitcnt vmcnt(0)" ::: "memory");
            const unsigned og = xb_add(&bar[XB_TOP], 1u);
            const unsigned tg = og / nx;
            if (og + 1u == (tg + 1u) * nx) xb_add(&bar[XB_TOPGEN], 1u);
            else XB_SPIN(xb_ld(&bar[XB_TOPGEN]) == tg, bar);
            __builtin_amdgcn_fence(__ATOMIC_ACQUIRE, "agent");
            xb_add(&bar[XB_XGEN(b.x)], 1u);
            asm volatile("s_waitcnt vmcnt(0)" ::: "memory");
        } else {
            XB_SPIN(xb_ld(&bar[XB_XGEN(b.x)]) == gen, bar);
            __builtin_amdgcn_fence(__ATOMIC_ACQUIRE, "agent");
            asm volatile("s_waitcnt vmcnt(0)" ::: "memory");
        }
    }
    __syncthreads();
}

struct Frame {
    LAS unsigned char* lds;
    unsigned char* ws;
    gu32* ctl;
    int tid, lane, wave;
    int vcu, G;
    const float* const* in;
    float* out;
};
constexpr int PTR_OFF = LDSCTL_OFF + 512;
__device__ __forceinline__ const float* inptr(LAS unsigned char* lds, int i) { const unsigned long long v = ((const LAS unsigned long long*)(lds + PTR_OFF))[i];
    return (const float*)(((unsigned long long)(unsigned)__builtin_amdgcn_readfirstlane((int)(unsigned)(v >> 32)) << 32) | (unsigned long long)(unsigned)__builtin_amdgcn_readfirstlane((int)(unsigned)v)); }
#define INP(i) inptr(F.lds, (i))
__device__ __forceinline__ float wave_sum(float v) {
#pragma unroll
    for (int o = 1; o < 64; o <<= 1) v += __shfl_xor(v, o);
    return v;
}

namespace pg8 {
__device__ __forceinline__ unsigned cvt_pk_f16(float lo, float hi) { typedef _Float16 h2 __attribute__((ext_vector_type(2))); h2 v = (h2){(_Float16)lo, (_Float16)hi}; return __builtin_bit_cast(unsigned, v); }
struct EpiInProj {
    static constexpr bool PERM = true;
    unsigned char* ws; const float* gq_a; const float* gq_b; const float* gk;
    __device__ __forceinline__ void operator()(const f32x4 (&acc)[2][2][4][2], const Unit& u, int wr, int wc, int fr_in, int fq_in) const {
        int fr = fr_in, fq = fq_in; asm volatile("" : "+v"(fr), "+v"(fq));
        const int pn = u.pn;
        int kind = 0; size_t dst = 0; int pitch = 512, cofs = 0; const float* gain = nullptr; float post = 1.f;
        if (pn < 2)       { kind = 1; dst = WS_QA; pitch = 512; cofs = (pn * 4 + wc) * 64; gain = gq_a; post = QSCALE; }
        else if (pn < 4)  { kind = 1; dst = WS_QB; pitch = 512; cofs = ((pn - 2) * 4 + wc) * 64; gain = gq_b; post = QSCALE; }
        else if (pn == 4) { kind = 1; dst = (wc < 2) ? WS_SK : WS_WK; pitch = 128; cofs = (wc & 1) * 64; gain = gk; }
        else if (pn == 5) { kind = 0; dst = (wc < 2) ? WS_CK : WS_CV; pitch = 128; cofs = (wc & 1) * 64; }
        else if (pn == 6) { kind = 0; dst = (wc < 2) ? WS_SV : WS_WV; pitch = 128; cofs = (wc & 1) * 64; }
        else if (pn < 9)  { kind = 5; dst = WS_IQ; pitch = 512; cofs = ((pn - 7) * 4 + wc) * 64; }
        else if (pn == 9) { if (wc < 2) { kind = 0; dst = WS_CKV; pitch = 128; cofs = wc * 64; } else if (wc == 2) { kind = 4; } else kind = 3; }
        else if (pn < 14) { kind = 2; dst = WS_GA; pitch = 1024; cofs = (pn - 10) * 256 + wc * 64; }
        else              { kind = 2; dst = WS_GB; pitch = 1024; cofs = (pn - 14) * 256 + wc * 64; }
        const int row0 = u.pm * BM + wr * 64 + fr;
        if (kind == 3) {
            float* IW = (float*)(ws + WS_IW); float* AG = (float*)(ws + WS_AG);
#pragma unroll
            for (int ai = 0; ai < 2; ++ai)
#pragma unroll
                for (int m = 0; m < 4; ++m) { const int row = row0 + ai * HALF + m * 16; const f32x4 v0 = acc[ai][0][m][0], v1 = acc[ai][0][m][1];
                    if (fq == 0) { const float s = 0.125f * 0.35355339059327373f; *(f32x4*)(IW + (size_t)row * 8) = v0 * s; *(f32x4*)(IW + (size_t)row * 8 + 4) = v1 * s; }
                    else { f32x4 a, b;
#pragma unroll
                        for (int i = 0; i < 4; ++i) { a[i] = sigmoidf_(v0[i]); b[i] = sigmoidf_(v1[i]); }
                        *(f32x4*)(AG + (size_t)row * 24 + (fq - 1) * 8) = a; *(f32x4*)(AG + (size_t)row * 24 + (fq - 1) * 8 + 4) = b; } }
            return;
        }
        if (kind == 4) {
            bf16_t* IKT = (bf16_t*)(ws + WS_IK);
#pragma unroll
            for (int ai = 0; ai < 2; ++ai)
#pragma unroll
                for (int m = 0; m < 4; ++m) { const int row = row0 + ai * HALF + m * 16; const int tb = row >> 5, within = row & 31;
#pragma unroll
                    for (int bj = 0; bj < 2; ++bj) { const f32x4 v0 = acc[ai][bj][m][0], v1 = acc[ai][bj][m][1]; const int sidx = 2 * bj + (fq >> 1);
                        u32x4 w; w.x = cvt_pk_f16(v0[0], v0[1]); w.y = cvt_pk_f16(v0[2], v0[3]); w.z = cvt_pk_f16(v1[0], v1[1]); w.w = cvt_pk_f16(v1[2], v1[3]);
                        *(u32x4*)(IKT + ((((size_t)tb * 4 + sidx) * 2 + (fq & 1)) * 32 + within) * 8) = w; } }
            return;
        }
        bf16_t* base = (bf16_t*)(ws + dst) + cofs + 8 * fq;
#pragma unroll
        for (int ai = 0; ai < 2; ++ai)
#pragma unroll
            for (int m = 0; m < 4; ++m) { bf16_t* rowp = base + (size_t)(row0 + ai * HALF + m * 16) * pitch;
                float r = 1.f;
                if (kind == 1) {
                    float ss = 0.f;
#pragma unroll
                    for (int bj = 0; bj < 2; ++bj)
#pragma unroll
                        for (int n = 0; n < 2; ++n) { const f32x4 x = acc[ai][bj][m][n]; ss += (x[0] * x[0] + x[1] * x[1]) + (x[2] * x[2] + x[3] * x[3]); }
                    ss += __shfl_xor(ss, 16); ss += __shfl_xor(ss, 32);
                    r = post / sqrtf(ss * (1.0f / 64.0f) + NORM_EPS);
                }
#pragma unroll
                for (int bj = 0; bj < 2; ++bj) { f32x4 v0 = acc[ai][bj][m][0], v1 = acc[ai][bj][m][1];
                    if (kind == 1) { const f32x4 g0 = *(const f32x4*)(gain + 32 * bj + 8 * fq), g1 = *(const f32x4*)(gain + 32 * bj + 8 * fq + 4); v0 = v0 * r * g0; v1 = v1 * r * g1; }
                    else if (kind == 2) {
#pragma unroll
                        for (int i = 0; i < 4; ++i) { v0[i] = sigmoidf_(v0[i]); v1[i] = sigmoidf_(v1[i]); } }
                    u32x4 w; if (kind == 5 || kind == 1) {   w.x = cvt_pk_f16(v0[0], v0[1]); w.y = cvt_pk_f16(v0[2], v0[3]); w.z = cvt_pk_f16(v1[0], v1[1]); w.w = cvt_pk_f16(v1[2], v1[3]); }
                    else { w.x = cvt_pk_bf16(v0[0], v0[1]); w.y = cvt_pk_bf16(v0[2], v0[3]); w.z = cvt_pk_bf16(v1[0], v1[1]); w.w = cvt_pk_bf16(v1[2], v1[3]); }
                    *(u32x4*)(rowp + 32 * bj) = w; } }
    }
};
template <int MODE> struct EpiMerge {
    static constexpr bool PERM = true;
    const bf16_t* G; bf16_t* O;
    __device__ __forceinline__ void operator()(const f32x4 (&acc)[2][2][4][2], const Unit& u, int wr, int wc, int fr_in, int fq_in) const {
        int fr = fr_in, fq = fq_in; asm volatile("" : "+v"(fr), "+v"(fq));
        const int row0 = u.pm * BM + wr * 64 + fr, col0 = u.pn * BM + wc * 32 + 8 * fq;
#pragma unroll
        for (int ai = 0; ai < 2; ++ai)
#pragma unroll
            for (int m = 0; m < 4; ++m) { const size_t off = (size_t)(row0 + ai * HALF + m * 16) * 1024 + col0;
#pragma unroll
                for (int bj = 0; bj < 2; ++bj) { const u32x4 gw = *(const u32x4*)(G + off + bj * HALF); const f32x4 a0 = acc[ai][bj][m][0], a1 = acc[ai][bj][m][1];
                    float r[8]; r[0] = bflo(gw.x) * a0[0]; r[1] = bfhi(gw.x) * a0[1]; r[2] = bflo(gw.y) * a0[2]; r[3] = bfhi(gw.y) * a0[3]; r[4] = bflo(gw.z) * a1[0]; r[5] = bfhi(gw.z) * a1[1]; r[6] = bflo(gw.w) * a1[2]; r[7] = bfhi(gw.w) * a1[3];
                    if (MODE == 1) { const u32x4 ow = *(const u32x4*)(O + off + bj * HALF); r[0] += bflo(ow.x); r[1] += bfhi(ow.x); r[2] += bflo(ow.y); r[3] += bfhi(ow.y); r[4] += bflo(ow.z); r[5] += bfhi(ow.z); r[6] += bflo(ow.w); r[7] += bfhi(ow.w); }
                    u32x4 w; w.x = cvt_pk_bf16(r[0], r[1]); w.y = cvt_pk_bf16(r[2], r[3]); w.z = cvt_pk_bf16(r[4], r[5]); w.w = cvt_pk_bf16(r[6], r[7]);
                    *(u32x4*)(O + off + bj * HALF) = w; } }
    }
};
struct EpiOut {
    static constexpr bool PERM = true;
    const float* X; float* O;
    __device__ __forceinline__ void operator()(const f32x4 (&acc)[2][2][4][2], const Unit& u, int wr, int wc, int fr_in, int fq_in) const {
        int fr = fr_in, fq = fq_in; asm volatile("" : "+v"(fr), "+v"(fq));
        const int row0 = u.pm * BM + wr * 64 + fr, col0 = u.pn * BM + wc * 32 + 8 * fq;
#pragma unroll
        for (int ai = 0; ai < 2; ++ai)
#pragma unroll
            for (int m = 0; m < 4; ++m) { const size_t off = (size_t)(row0 + ai * HALF + m * 16) * 1024 + col0;
#pragma unroll
                for (int bj = 0; bj < 2; ++bj)
#pragma unroll
                    for (int n = 0; n < 2; ++n) *(f32x4*)(O + off + bj * HALF + 4 * n) = *(const f32x4*)(X + off + bj * HALF + 4 * n) + acc[ai][bj][m][n]; }
    }
};
__device__ __forceinline__ float swiglu1(float g, float l) { g = fminf(g, 7.0f); l = fminf(fmaxf(l, -7.0f), 7.0f); return g * fast_rcp(1.f + fast_exp2(-1.702f * LOG2E * g)) * (l + 1.0f); }
struct EpiSwiglu {
    static constexpr bool PERM = true;
    bf16_t* ACT; const float* bgu;
    __device__ __forceinline__ void operator()(const f32x4 (&acc)[2][2][4][2], const Unit& u, int wr, int wc, int fr_in, int fq_in) const {
        int fr = fr_in, fq = fq_in; asm volatile("" : "+v"(fr), "+v"(fq));
        const int e = u.pb >> 3, row0 = u.pm * BM + wr * 64 + fr, colt = u.pn * BM + wc * 32 + 8 * fq;
        f32x4 bv[2][2];
#pragma unroll
        for (int bj = 0; bj < 2; ++bj)
#pragma unroll
            for (int n = 0; n < 2; ++n) bv[bj][n] = *(const f32x4*)(bgu + (size_t)e * 2048 + colt + bj * HALF + 4 * n);
#pragma unroll
        for (int ai = 0; ai < 2; ++ai)
#pragma unroll
            for (int m = 0; m < 4; ++m) { bf16_t* rowp = ACT + (size_t)(row0 + ai * HALF + m * 16) * 1024 + (colt >> 1);
#pragma unroll
                for (int bj = 0; bj < 2; ++bj) { const f32x4 v0 = acc[ai][bj][m][0] + bv[bj][0], v1 = acc[ai][bj][m][1] + bv[bj][1];
                    u32x2 w; w.x = cvt_pk_bf16(swiglu1(v0[0], v0[1]), swiglu1(v0[2], v0[3])); w.y = cvt_pk_bf16(swiglu1(v1[0], v1[1]), swiglu1(v1[2], v1[3]));
                    *(u32x2*)(rowp + bj * 64) = w; } }
    }
};
struct EpiDown {
    static constexpr bool PERM = true;
    bf16_t* YF; bf16_t* ACT; bf16_t* YX; const float* bd; const float* rowgate; int pmfull; bool dry;
    __device__ __forceinline__ void operator()(const f32x4 (&acc)[2][2][4][2], const Unit& u, int wr, int wc, int fr_in, int fq_in) const {
        int fr = fr_in, fq = fq_in; asm volatile("" : "+v"(fr), "+v"(fq));
        const int e = u.pb >> 2, rl = wr * 64 + fr, colt = u.pn * BM + wc * 32 + 8 * fq;
        bf16_t* ybase = (u.pm < 256) ? YF + (size_t)u.pm * BM * 1024 : (u.pm < pmfull) ? ACT + (size_t)(u.pm - 256) * BM * 1024 : YX + (size_t)(u.pm - pmfull) * BM * 1024;
        f32x4 bv[2][2];
#pragma unroll
        for (int bj = 0; bj < 2; ++bj)
#pragma unroll
            for (int n = 0; n < 2; ++n) bv[bj][n] = *(const f32x4*)(bd + (size_t)e * 1024 + colt + bj * HALF + 4 * n);
#pragma unroll
        for (int ai = 0; ai < 2; ++ai)
#pragma unroll
            for (int m = 0; m < 4; ++m) { const int r = rl + ai * HALF + m * 16; const float gt = rowgate[u.pm * BM + r]; bf16_t* rowp = ybase + (size_t)r * 1024 + colt;
#pragma unroll
                for (int bj = 0; bj < 2; ++bj) { const f32x4 y0 = (acc[ai][bj][m][0] + bv[bj][0]) * gt, y1 = (acc[ai][bj][m][1] + bv[bj][1]) * gt;
                    u32x4 w; w.x = cvt_pk_bf16(y0[0], y0[1]); w.y = cvt_pk_bf16(y0[2], y0[3]); w.z = cvt_pk_bf16(y1[0], y1[1]); w.w = cvt_pk_bf16(y1[2], y1[3]);
                    if (!dry || w.x == 0x12345678u) *(u32x4*)(rowp + bj * HALF) = w; } }
    }
};
}

__device__ __forceinline__ void p0_transpose_item(const float* W, int K, int N, bf16* WT, LAS float* scr, int item, int lane, const float* kscale) {
    const int nblk = N / 32, kb = item / nblk, nb = item % nblk, k0 = 64 * kb, n0 = 32 * nb;
    f32x4 v[8];
#pragma unroll
    for (int i = 0; i < 8; ++i) { const int kk = 8 * i + (lane >> 3); v[i] = *(const GAS f32x4*)(W + (size_t)(k0 + kk) * N + n0 + 4 * (lane & 7)); if (kscale) v[i] = v[i] * kscale[k0 + kk]; }
#pragma unroll
    for (int i = 0; i < 8; ++i) { const int kk = 8 * i + (lane >> 3); LAS float* d = scr + kk * 33 + 4 * (lane & 7); d[0] = v[i].x; d[1] = v[i].y; d[2] = v[i].z; d[3] = v[i].w; }
    LDS_WAIT(); asm volatile("" ::: "memory");
    const int c = lane & 7;
#pragma unroll
    for (int j = 0; j < 4; ++j) { const int n = (lane >> 3) + 8 * j; const LAS float* s = scr + (8 * c) * 33 + n;
        v4u o; o.x = pk2(s[0 * 33], s[1 * 33]); o.y = pk2(s[2 * 33], s[3 * 33]); o.z = pk2(s[4 * 33], s[5 * 33]); o.w = pk2(s[6 * 33], s[7 * 33]);
        *(GAS v4u*)(WT + (size_t)(n0 + n) * K + k0 + 8 * c) = o; }
    LDS_WAIT(); asm volatile("" ::: "memory");
}
__device__ __forceinline__ int win_src_col(int p) {
    const int pn = p >> 8, rem = p & 255, bj = rem >> 7, wc = (rem >> 5) & 3, j = rem & 31, hs = pn * 4 + wc, dim = 32 * bj + j;
    if (hs < 8) return hs * 64 + dim;
    if (hs < 16) return 1304 + (hs - 8) * 64 + dim;
    if (hs < 18) return 768 + (hs - 16) * 64 + dim;
    if (hs < 20) return 1024 + (hs - 18) * 64 + dim;
    if (hs < 22) return 512 + (hs - 20) * 64 + dim;
    if (hs < 24) return 640 + (hs - 22) * 64 + dim;
    if (hs < 26) return 896 + (hs - 24) * 64 + dim;
    if (hs < 28) return 1152 + (hs - 26) * 64 + dim;
    if (hs < 36) return 1944 + (hs - 28) * 64 + dim;
    if (hs < 38) return 1816 + (hs - 36) * 64 + dim;
    if (hs == 38) return 2456 + dim;
    if (hs == 39) return dim < 8 ? 2520 + dim : (dim < 32 ? 1280 + (dim - 8) : -1);
    if (hs < 56) return 2528 + (hs - 40) * 64 + dim;
    return 3552 + (hs - 56) * 64 + dim;
}
__device__ __forceinline__ void p0_win_item(const float* W, bf16* WT, LAS float* scr, int item, int lane) {
    const int nblk = NPIN / 32, kb = item / nblk, nb = item % nblk, k0 = 64 * kb, n0 = 32 * nb;
    const int col = win_src_col(n0 + (lane & 31));
#pragma unroll 8
    for (int i = 0; i < 32; ++i) { const int kk = 2 * i + (lane >> 5); scr[kk * 33 + (lane & 31)] = col >= 0 ? W[(size_t)(k0 + kk) * DIN + col] : 0.f; }
    LDS_WAIT(); asm volatile("" ::: "memory");
    const int c = lane & 7;
#pragma unroll
    for (int j = 0; j < 4; ++j) { const int n = (lane >> 3) + 8 * j; const LAS float* s = scr + (8 * c) * 33 + n;
        v4u o; o.x = pk2(s[0 * 33], s[1 * 33]); o.y = pk2(s[2 * 33], s[3 * 33]); o.z = pk2(s[4 * 33], s[5 * 33]); o.w = pk2(s[6 * 33], s[7 * 33]);
        *(GAS v4u*)(WT + (size_t)(n0 + n) * 1024 + k0 + 8 * c) = o; }
    LDS_WAIT(); asm volatile("" ::: "memory");
}
__device__ __forceinline__ void rms_row_to_bf16(const float* xrow, const float* gain, bf16* orow, int lane) {
    const GAS f32x4* xr = (const GAS f32x4*)xrow + lane; const GAS f32x4* gr = (const GAS f32x4*)gain + lane;
    f32x4 v[4]; float s = 0.f;
#pragma unroll
    for (int j = 0; j < 4; ++j) { v[j] = xr[64 * j]; s += (v[j].x * v[j].x + v[j].y * v[j].y) + (v[j].z * v[j].z + v[j].w * v[j].w); }
    const float r = 1.f / sqrtf(wave_sum(s) * (1.f / DM) + NORM_EPS);
    GAS unsigned long long* o8 = (GAS unsigned long long*)orow + lane;
#pragma unroll
    for (int j = 0; j < 4; ++j) { const f32x4 g = gr[64 * j]; o8[64 * j] = (unsigned long long)pk2(v[j].x * r * g.x, v[j].y * r * g.y) | ((unsigned long long)pk2(v[j].z * r * g.z, v[j].w * r * g.w) << 32); }
}

struct Args { const float* in[29]; float* out; unsigned char* ws; int ph_lo, ph_hi, dup, mode; };

__device__ __forceinline__ void p0_prologue(Frame& F, const Args& A) {
    LAS float* scr = (LAS float*)(F.lds + RING_OFF + F.wave * 16384);
    int lane_ = F.lane; asm volatile("" : "+v"(lane_));
    const int gw = F.vcu * NWAVES + F.wave, NGW = F.G * NWAVES, lane = lane_;
    unsigned char* ws = F.ws;
    constexpr int I_WIN = (DM / 64) * (NPIN / 32);
    constexpr int I_WA = (512 / 64) * (1024 / 32);
    constexpr int I_WO = (1024 / 64) * (1024 / 32);
    constexpr int I_W1 = (1024 / 64) * (2048 / 32);
    constexpr int I_W2 = (1024 / 64) * (1024 / 32);
    constexpr int I_CW1 = (2048 / 64) * (128 / 32);
    constexpr int I_CW2 = (128 / 64) * (64 / 32);
    constexpr int NITEMS = I_WIN + 2 * I_WA + I_WO + 2 * I_CW1 + 4 * I_CW2;
    for (int it = gw; it < NITEMS; it += NGW) {
        int r = it;
        if (r < I_WIN) { p0_win_item(INP(2), (bf16*)(ws + WS_WIN), scr, r, lane); continue; } r -= I_WIN;
        if (r < I_WA) { p0_transpose_item(INP(18), 512, 1024, (bf16*)(ws + WS_WA), scr, r, lane, nullptr); continue; } r -= I_WA;
        if (r < I_WA) { p0_transpose_item(INP(19), 512, 1024, (bf16*)(ws + WS_WB), scr, r, lane, nullptr); continue; } r -= I_WA;
        if (r < I_WO) { p0_transpose_item(INP(20), 1024, 1024, (bf16*)(ws + WS_WO), scr, r, lane, nullptr); continue; } r -= I_WO;
        if (r < I_CW1) { p0_transpose_item(INP(6), 2048, 128, (bf16*)(ws + WS_CW1K), scr, r, lane, nullptr); continue; } r -= I_CW1;
        if (r < I_CW1) { p0_transpose_item(INP(10), 2048, 128, (bf16*)(ws + WS_CW1V), scr, r, lane, nullptr); continue; } r -= I_CW1;
        if (r < I_CW2) { p0_transpose_item(INP(8), 128, 64, (bf16*)(ws + WS_CW2K), scr, r, lane, nullptr); continue; } r -= I_CW2;
        if (r < I_CW2) { p0_transpose_item(INP(12), 128, 64, (bf16*)(ws + WS_CW2V), scr, r, lane, nullptr); continue; } r -= I_CW2;
        if (r < I_CW2) { p0_transpose_item(INP(14), 128, 64, (bf16*)(ws + WS_WUK), scr, r, lane, INP(13)); continue; } r -= I_CW2;
        p0_transpose_item(INP(15), 128, 64, (bf16*)(ws + WS_WUV), scr, r, lane, INP(13));
    }
    { const float* X = INP(0); const GAS f32x4* gr = (const GAS f32x4*)INP(1) + lane; bf16* XN = (bf16*)(ws + WS_XN);
      for (int m = gw; m < NTOK; m += 2 * NGW) {
        f32x4 v[2][4]; float sq[2];
#pragma unroll
        for (int u = 0; u < 2; ++u) { const GAS f32x4* xr = (const GAS f32x4*)(X + (size_t)(m + u * NGW) * DM) + lane;
#pragma unroll
            for (int j = 0; j < 4; ++j) v[u][j] = xr[64 * j]; }
#pragma unroll
        for (int u = 0; u < 2; ++u) { float s_ = 0.f;
#pragma unroll
            for (int j = 0; j < 4; ++j) s_ += (v[u][j].x * v[u][j].x + v[u][j].y * v[u][j].y) + (v[u][j].z * v[u][j].z + v[u][j].w * v[u][j].w);
            sq[u] = s_; }
#pragma unroll
        for (int o = 1; o < 64; o <<= 1) { sq[0] += __shfl_xor(sq[0], o); sq[1] += __shfl_xor(sq[1], o); }
#pragma unroll
        for (int u = 0; u < 2; ++u) { const float r = 1.f / sqrtf(sq[u] * (1.f / DM) + NORM_EPS); GAS unsigned long long* o8 = (GAS unsigned long long*)(XN + (size_t)(m + u * NGW) * DM) + lane;
#pragma unroll
            for (int j = 0; j < 4; ++j) { const f32x4 g = gr[64 * j]; o8[64 * j] = (unsigned long long)pk2(v[u][j].x * r * g.x, v[u][j].y * r * g.y) | ((unsigned long long)pk2(v[u][j].z * r * g.z, v[u][j].w * r * g.w) << 32); } }
      } }
    const int gt = F.vcu * (NWAVES * 64) + F.tid, NGT = F.G * NWAVES * 64;
    { float* wrp = (float*)(ws + WS_WRP); const float* wr = INP(23); const float* fg = INP(22);
      for (int i = gt; i < 1024 * 32; i += NGT) wrp[i] = wr[i] * fg[i >> 5]; }
    { float* lut = (float*)(ws + WS_BIASLUT); const float* rb = INP(21);
      for (int i = gt; i < 16 * 128 + 16; i += NGT) { if (i < 2048) { const int h = i >> 7, n = i & 127; lut[i] = rb[(int)REL_BUCKET[n] * 16 + h] * LOG2E; } else lut[i] = rb[31 * 16 + (i - 2048)] * LOG2E; }
      if (gt == 0) { for (int br = 0; br < 2; ++br) { const float* gq = br ? INP(16) : INP(3); const float* gk = br ? INP(17) : INP(4); float mq = 0.f, mk = 0.f; for (int i = 0; i < 64; ++i) { mq = fmaxf(mq, fabsf(gq[i])); mk = fmaxf(mk, fabsf(gk[i])); } lut[2064 + br] = 64.0f * QSCALE * mq * mk; } } }
    if (gw >= NGW - 8) { const int it = gw - (NGW - 8), mat = it >> 2, cg = it & 3; const float* pe = INP(mat ? 9 : 5); const float* w1 = INP(mat ? 10 : 6); const float* b1 = INP(mat ? 11 : 7);
        const int c = cg * 32 + (lane & 31), kh = lane >> 5; float s = 0.f;
#pragma unroll 8
        for (int k = 0; k < 1024; ++k) { const int kk = kh * 1024 + k; s += pe[kk] * w1[(size_t)kk * 128 + c]; }
        s += __shfl_xor(s, 32);
        if (lane < 32) ((float*)(ws + (mat ? WS_CB1V : WS_CB1K)))[c] = s + b1[c]; }
}

__device__ __forceinline__ void moe_weight_items(Frame& F, int gw2, int ngw2, int lane) {
    LAS float* scr = (LAS float*)(F.lds + RING_OFF + F.wave * 16384); unsigned char* ws = F.ws;
    constexpr int I_W1 = (1024 / 64) * (2048 / 32), I_W2 = (1024 / 64) * (1024 / 32);
    for (int it = gw2; it < NEXP * (I_W1 + I_W2); it += ngw2) {
        if (it < NEXP * I_W1) { const int e = it / I_W1; p0_transpose_item(INP(25) + (size_t)e * 1024 * 2048, 1024, 2048, (bf16*)(ws + WS_W1T) + (size_t)e * 2048 * 1024, scr, it % I_W1, lane, nullptr); }
        else { const int r = it - NEXP * I_W1, e = r / I_W2; p0_transpose_item(INP(27) + (size_t)e * 1024 * 1024, 1024, 1024, (bf16*)(ws + WS_W2T) + (size_t)e * 1024 * 1024, scr, r % I_W2, lane, nullptr); }
    }
}
__device__ __forceinline__ void router_phase(Frame& F, const Args& A, const bool dry = false) {
    unsigned char* ws = F.ws; int tid_ = F.tid; asm volatile("" : "+v"(tid_)); const int tid = tid_, lane = tid & 63, w = F.wave;
    LAS float* part = (LAS float*)(F.lds);
    LAS float* ssq = (LAS float*)(F.lds + 34816);
    LAS float* lg = (LAS float*)(F.lds + 36864);
    LAS float* rinv = (LAS float*)(F.lds + 41216);
    LAS int* pe = (LAS int*)(F.lds + 41472);
    LAS float* pg = (LAS float*)(F.lds + 41984);
    LAS int* plp = (LAS int*)(F.lds + 42496);
    LAS int* hist = (LAS int*)(F.lds + 43008);
    LAS int* hbase = (LAS int*)(F.lds + 43136);
    const float* wrp = (const float*)(ws + WS_WRP); const float* fg = INP(22); const float* br = INP(24);
    bf16* XN2 = (bf16*)(ws + WS_XN);
    const int i = lane & 31, h = lane >> 5, kb = 128 * w + 64 * h;
    for (int unit = F.vcu; unit < NTOK / 32; unit += F.G) {
        const int t0 = unit * 32;
        if (tid < 32) hist[tid] = 0;
        const float* xr = F.out + (size_t)(t0 + i) * DM + kb;
        f32x4 xa[16];
#pragma unroll
        for (int j = 0; j < 16; ++j) xa[j] = *(const GAS f32x4*)(xr + 4 * j);
        f32x16 acc;
#pragma unroll
        for (int r = 0; r < 16; ++r) acc[r] = 0.f;
        float ss = 0.f;
#pragma unroll
        for (int s = 0; s < 64; ++s) { const float a = xa[s >> 2][s & 3]; const float b = wrp[(size_t)(kb + s) * 32 + i]; acc = __builtin_amdgcn_mfma_f32_32x32x2f32(a, b, acc, 0, 0, 0); ss += a * a; }
#pragma unroll
        for (int r = 0; r < 16; ++r) part[(w * 32 + ((r & 3) + 8 * (r >> 2) + 4 * h)) * 33 + i] = acc[r];
        ssq[w * 64 + lane] = ss;
        __syncthreads();
        { const int tk = tid >> 4, e0 = (tid & 15) * 2; float s = 0.f;
#pragma unroll
          for (int ww = 0; ww < 8; ++ww) s += ssq[ww * 64 + tk] + ssq[ww * 64 + tk + 32];
          const float r = 1.f / sqrtf(s * (1.f / DM) + NORM_EPS);
          if ((tid & 15) == 0) rinv[tk] = r;
          float v0 = 0.f, v1 = 0.f;
#pragma unroll
          for (int ww = 0; ww < 8; ++ww) { v0 += part[(ww * 32 + tk) * 33 + e0]; v1 += part[(ww * 32 + tk) * 33 + e0 + 1]; }
          lg[tk * 33 + e0] = v0 * r + br[e0]; lg[tk * 33 + e0 + 1] = v1 * r + br[e0 + 1]; }
        __syncthreads();
        if (tid < 32) {
            float tv[4] = {-3.0e38f, -3.0e38f, -3.0e38f, -3.0e38f}; int te[4] = {0, 0, 0, 0};
#pragma unroll
            for (int e = 0; e < 32; ++e) { const float v = lg[tid * 33 + e];
                if (v > tv[3]) { tv[3] = v; te[3] = e;
                    if (tv[3] > tv[2]) { float a = tv[2]; tv[2] = tv[3]; tv[3] = a; int b = te[2]; te[2] = te[3]; te[3] = b;
                        if (tv[2] > tv[1]) { a = tv[1]; tv[1] = tv[2]; tv[2] = a; b = te[1]; te[1] = te[2]; te[2] = b;
                            if (tv[1] > tv[0]) { a = tv[0]; tv[0] = tv[1]; tv[1] = a; b = te[0]; te[0] = te[1]; te[1] = b; } } } } }
            float p[4], sum = 0.f;
#pragma unroll
            for (int k = 0; k < 4; ++k) { p[k] = __expf(tv[k] - tv[0]); sum += p[k]; }
            const float inv = 1.f / sum;
#pragma unroll
            for (int k = 0; k < 4; ++k) { pe[tid * 4 + k] = te[k]; pg[tid * 4 + k] = p[k] * inv; plp[tid * 4 + k] = atomicAdd((int*)&hist[te[k]], 1); }
        }
        { const float r = rinv[i]; bf16* orow = XN2 + (size_t)(t0 + i) * DM + kb;
#pragma unroll
          for (int j = 0; j < 16; ++j) { const f32x4 g = *(const GAS f32x4*)(fg + kb + 4 * j); const f32x4 v = xa[j] * r * g; v2u o; o.x = pk2(v.x, v.y); o.y = pk2(v.z, v.w); *(GAS v2u*)(orow + 4 * j) = o; } }
        __syncthreads();
        if (tid < 32) { const int n = hist[tid]; hbase[tid] = (n && !dry) ? (int)__hip_atomic_fetch_add((unsigned*)(F.ctl + CW_CNT + 64 * tid), (unsigned)n, RLX_AGENT) : 0; }
        __syncthreads();
        if (tid < 32 && !dry) {
            int* TE = (int*)(ws + WS_TOKE); float* TG = (float*)(ws + WS_TOKG); int* TP = (int*)(ws + WS_TOKP);
#pragma unroll
            for (int k = 0; k < 4; ++k) { const int e = pe[tid * 4 + k]; TE[(t0 + tid) * 4 + k] = e; TG[(t0 + tid) * 4 + k] = pg[tid * 4 + k]; TP[(t0 + tid) * 4 + k] = hbase[e] + plp[tid * 4 + k]; }
        }
        __syncthreads();
    }
}

__device__ __forceinline__ void dispatch_phase(Frame& F) {
    unsigned char* ws = F.ws; const int tid = F.tid;
    LAS int* pstart = (LAS int*)(F.lds);
    LAS int* cnts = (LAS int*)(F.lds + 256);
    if (tid < 32) cnts[tid] = (int)__hip_atomic_load((unsigned*)(F.ctl + CW_CNT + 64 * tid), RLX_AGENT);
    __syncthreads();
    if (tid == 0) { int a = 0; for (int e = 0; e < 32; ++e) { pstart[e] = a; a += (cnts[e] + 255) & ~255; } pstart[32] = a; }
    __syncthreads();
    int* TILEE = (int*)(ws + WS_TILEE); int* ROWTOK = (int*)(ws + WS_ROWTOK); float* ROWGATE = (float*)(ws + WS_ROWGATE);
    if (blockIdx.x == 0) {
        const int T = pstart[32] >> 8;
        for (int pm = tid; pm < T; pm += NWAVES * 64) { int e = 0; for (int q = 1; q < 32; ++q) if (pstart[q] <= pm * 256) e = q; TILEE[pm] = e; }
        if (tid == 0) TILEE[2048] = T;
    }
    if (blockIdx.x < 32) { const int e = blockIdx.x; for (int r = pstart[e] + cnts[e] + tid; r < pstart[e + 1]; r += NWAVES * 64) { ROWTOK[r] = -1; ROWGATE[r] = 0.f; } }
    const int* TE = (const int*)(ws + WS_TOKE); const float* TG = (const float*)(ws + WS_TOKG); const int* TP = (const int*)(ws + WS_TOKP);
    for (int idx = blockIdx.x * (NWAVES * 64) + tid; idx < NTOK * TOPK; idx += F.G * NWAVES * 64) { const int e = TE[idx]; const int row = pstart[e] + TP[idx]; ROWTOK[row] = idx >> 2; ROWGATE[row] = TG[idx]; ((int*)(ws + WS_TOKP))[idx] = row; }
    __syncthreads();
}

__device__ __forceinline__ void combine_phase(Frame& F, const bool dry) {
    unsigned char* ws = F.ws; const int lane = F.lane; const int gw = F.vcu * NWAVES + F.wave, NGW = F.G * NWAVES;
    const int* TROW = (const int*)(ws + WS_TOKP); const bf16* YF = (const bf16*)(ws + WS_XN); const bf16* YA = (const bf16*)(ws + WS_ACT); const bf16* YX = (const bf16*)(ws + WS_YX);
    const int rowfull = (__builtin_amdgcn_readfirstlane(((const int*)(ws + WS_TILEE))[2048]) / 256) * 65536;
    for (int tok0 = gw; tok0 < NTOK; tok0 += 2 * NGW) {
        float* op[2]; f32x4 a[2][4]; v4u y[2][4][2];
#pragma unroll
        for (int u = 0; u < 2; ++u) { const int tok = tok0 + u * NGW; op[u] = F.out + (size_t)tok * DM + lane * 16;
#pragma unroll
            for (int k = 0; k < 4; ++k) { const int row = __builtin_amdgcn_readfirstlane(TROW[tok * 4 + k]);
                const bf16* yp = (row < 65536 ? YF + (size_t)row * 1024 : row < rowfull ? YA + (size_t)(row - 65536) * 1024 : YX + (size_t)(row - rowfull) * 1024) + lane * 16;
                y[u][k][0] = *(const GAS v4u*)yp; y[u][k][1] = *(const GAS v4u*)(yp + 8); }
#pragma unroll
            for (int j = 0; j < 4; ++j) a[u][j] = *(const GAS f32x4*)(op[u] + 4 * j); }
#pragma unroll
        for (int u = 0; u < 2; ++u) {
#pragma unroll
            for (int k = 0; k < 4; ++k) { const v4u y0 = y[u][k][0], y1 = y[u][k][1];
                a[u][0] += (f32x4){bflo(y0.x), bfhi(y0.x), bflo(y0.y), bfhi(y0.y)}; a[u][1] += (f32x4){bflo(y0.z), bfhi(y0.z), bflo(y0.w), bfhi(y0.w)};
                a[u][2] += (f32x4){bflo(y1.x), bfhi(y1.x), bflo(y1.y), bfhi(y1.y)}; a[u][3] += (f32x4){bflo(y1.z), bfhi(y1.z), bflo(y1.w), bfhi(y1.w)}; }
            if (!dry) {
#pragma unroll
                for (int j = 0; j < 4; ++j) *(GAS f32x4*)(op[u] + 4 * j) = a[u][j];
            } else if (a[u][0].x == 1.2345e30f) *(GAS f32x4*)(op[u]) = a[u][1] + a[u][2] + a[u][3]; }
    }
}

__device__ __forceinline__ f32x16 mfma32(bf16x8 a, bf16x8 b, f32x16 c) { return __builtin_amdgcn_mfma_f32_32x32x16_bf16(a, b, c, 0, 0, 0); }
typedef _Float16 f16x8 __attribute__((ext_vector_type(8)));
__device__ __forceinline__ f32x16 mfma32h(bf16x8 a, bf16x8 b, f32x16 c) { return __builtin_amdgcn_mfma_f32_32x32x16_f16(__builtin_bit_cast(f16x8, a), __builtin_bit_cast(f16x8, b), c, 0, 0, 0); }
__device__ __forceinline__ float half_sum(float x) { auto t = __builtin_amdgcn_permlane32_swap(__float_as_uint(x), __float_as_uint(x), false, false); return __uint_as_float(t[0]) + __uint_as_float(t[1]); }
__device__ __forceinline__ float half_max(float x) { auto t = __builtin_amdgcn_permlane32_swap(__float_as_uint(x), __float_as_uint(x), false, false); return fmaxf(__uint_as_float(t[0]), __uint_as_float(t[1])); }
__device__ __forceinline__ f32x16 zero16() { f32x16 z;
#pragma unroll
    for (int i = 0; i < 16; ++i) z[i] = 0.f; return z; }
__device__ __forceinline__ bf16x8 pack8(const f32x16& p, int base) {
    v4u w; w.x = pg8::cvt_pk_bf16(p[base + 0], p[base + 1]); w.y = pg8::cvt_pk_bf16(p[base + 2], p[base + 3]); w.z = pg8::cvt_pk_bf16(p[base + 4], p[base + 5]); w.w = pg8::cvt_pk_bf16(p[base + 6], p[base + 7]);
    return __builtin_bit_cast(bf16x8, w); }
__device__ __forceinline__ unsigned ord_key(float f) { const unsigned u = __float_as_uint(f); return (u & 0x80000000u) ? ~u : (u | 0x80000000u); }
__device__ __forceinline__ float gelu_tanh(float x) { const float u = 0.7978845608028654f * (x + 0.044715f * x * x * x); return x * fast_rcp(1.f + fast_exp2(-2.f * LOG2E * u)); }
constexpr float NEG_INF = -__builtin_inff();
__device__ __forceinline__ float dpp_xor1(float x) { return __builtin_bit_cast(float, __builtin_amdgcn_mov_dpp(__builtin_bit_cast(int, x), 0xB1, 0xf, 0xf, true)); }
__device__ __forceinline__ float dpp_xor2(float x) { return __builtin_bit_cast(float, __builtin_amdgcn_mov_dpp(__builtin_bit_cast(int, x), 0x4E, 0xf, 0xf, true)); }
typedef float f32x2 __attribute__((ext_vector_type(2)));
__device__ __forceinline__ float relu_i(float x) { const int b = __builtin_bit_cast(int, x); return __builtin_bit_cast(float, b > 0 ? b : 0); }
__device__ __forceinline__ float vmax(float a, float b) { float r; asm("v_max_f32_e32 %0, %1, %2" : "=v"(r) : "v"(a), "v"(b)); return r; }

__device__ __forceinline__ void small_phase(Frame& F, const Args& A) {
    unsigned char* ws = F.ws; int lane_ = F.lane; asm volatile("" : "+v"(lane_)); const int lane = lane_, q = lane & 31, hh = lane >> 5;
    const int gw = F.vcu * NWAVES + F.wave, NGW = F.G * NWAVES;
    for (int un = (F.wave < 2 && F.G == 256) ? F.vcu + 256 * F.wave : ((F.G == 256) ? 512 : gw); un < 512; un += (F.G == 256) ? 512 : NGW) {
        const int mat = un >> 8, bg = (un >> 4) & 15, ib = un & 15, b = bg >> 1, g = bg & 1;
        const bf16* SRC = (const bf16*)(ws + (mat ? WS_CV : WS_CK)); const bf16* W1T = (const bf16*)(ws + (mat ? WS_CW1V : WS_CW1K)); const bf16* W2T = (const bf16*)(ws + (mat ? WS_CW2V : WS_CW2K));
        const float* B1 = (const float*)(ws + (mat ? WS_CB1V : WS_CB1K)); const float* b2dummy = nullptr; (void)b2dummy;
        const int ci = ib * 32 + q;
        const int tokb = 16 * ci;
        f32x16 acc[4];
#pragma unroll
        for (int mt = 0; mt < 4; ++mt) acc[mt] = zero16();
#pragma unroll 4
        for (int s = 0; s < 128; ++s) {
            const int k = 16 * s + 8 * hh; int tok = tokb + (k >> 6); tok = tok > SEQ - 1 ? SEQ - 1 : tok;
            const bf16x8 bf = *(const GAS bf16x8*)(SRC + ((size_t)(b * SEQ + tok)) * 128 + g * 64 + (k & 63));
#pragma unroll
            for (int mt = 0; mt < 4; ++mt) { const bf16x8 af = *(const GAS bf16x8*)(W1T + (size_t)(32 * mt + q) * 2048 + k); acc[mt] = mfma32(af, bf, acc[mt]); }
        }
#pragma unroll
        for (int mt = 0; mt < 4; ++mt)
#pragma unroll
            for (int r = 0; r < 16; ++r) { const int hid = 32 * mt + (r & 3) + 8 * (r >> 2) + 4 * hh; acc[mt][r] = gelu_tanh(acc[mt][r] + B1[hid]); }
        f32x16 o[2]; o[0] = zero16(); o[1] = zero16();
#pragma unroll
        for (int s2 = 0; s2 < 8; ++s2) { const bf16x8 bf = pack8(acc[s2 >> 1], 8 * (s2 & 1));
#pragma unroll
            for (int dt = 0; dt < 2; ++dt) { const bf16* wp = W2T + (size_t)(32 * dt + q) * 128 + 32 * (s2 >> 1) + 16 * (s2 & 1) + 4 * hh;
                const v2u a0 = *(const GAS v2u*)wp, a1 = *(const GAS v2u*)(wp + 8); v4u aw; aw.x = a0.x; aw.y = a0.y; aw.z = a1.x; aw.w = a1.y;
                o[dt] = mfma32(__builtin_bit_cast(bf16x8, aw), bf, o[dt]); } }
        if (mat == 0) {
            float ss = 0.f;
#pragma unroll
            for (int dt = 0; dt < 2; ++dt)
#pragma unroll
                for (int r = 0; r < 16; ++r) ss += o[dt][r] * o[dt][r];
            ss = half_sum(ss); const float rn = 1.f / sqrtf(ss * (1.f / 64.f) + NORM_EPS); const float* gk = INP(4);
#pragma unroll
            for (int dt = 0; dt < 2; ++dt)
#pragma unroll
                for (int r = 0; r < 16; ++r) o[dt][r] *= rn * gk[32 * dt + (r & 3) + 8 * (r >> 2) + 4 * hh];
        }
        bf16* DST = (bf16*)(ws + (mat ? WS_VC : WS_KC)) + ((size_t)bg * 512 + ci) * 64;
        const bool valid = ci < NCMP;
#pragma unroll
        for (int dt = 0; dt < 2; ++dt)
#pragma unroll
            for (int gq = 0; gq < 4; ++gq) { v2u w; w.x = !valid ? 0u : (mat == 0 ? pg8::cvt_pk_f16(o[dt][4 * gq], o[dt][4 * gq + 1]) : pg8::cvt_pk_bf16(o[dt][4 * gq], o[dt][4 * gq + 1])); w.y = !valid ? 0u : (mat == 0 ? pg8::cvt_pk_f16(o[dt][4 * gq + 2], o[dt][4 * gq + 3]) : pg8::cvt_pk_bf16(o[dt][4 * gq + 2], o[dt][4 * gq + 3]));
                *(GAS v2u*)(DST + 32 * dt + 8 * gq + 4 * hh) = w; }
    }
    if (F.G == 256) { if (F.wave >= 2) moe_weight_items(F, F.vcu * 6 + (F.wave - 2), F.G * 6, lane); } else moe_weight_items(F, gw, NGW, lane);
    { const bf16* CKV = (const bf16*)(ws + WS_CKV); const bf16* WUK = (const bf16*)(ws + WS_WUK); const bf16* WUV = (const bf16*)(ws + WS_WUV); const float* gk = INP(17);
      for (int un = gw; un < NTOK / 32; un += NGW) {
        const size_t tok = (size_t)un * 32 + q;
        f32x16 ok[2], ov[2]; ok[0] = zero16(); ok[1] = zero16(); ov[0] = zero16(); ov[1] = zero16(); float ss = 0.f;
#pragma unroll
        for (int s = 0; s < 8; ++s) { const int k = 16 * s + 8 * hh; const v4u bw = *(const GAS v4u*)(CKV + tok * 128 + k);
            ss += bflo(bw.x) * bflo(bw.x) + bfhi(bw.x) * bfhi(bw.x) + bflo(bw.y) * bflo(bw.y) + bfhi(bw.y) * bfhi(bw.y) + bflo(bw.z) * bflo(bw.z) + bfhi(bw.z) * bfhi(bw.z) + bflo(bw.w) * bflo(bw.w) + bfhi(bw.w) * bfhi(bw.w);
            const bf16x8 bf = __builtin_bit_cast(bf16x8, bw);
#pragma unroll
            for (int dt = 0; dt < 2; ++dt) { ok[dt] = mfma32(*(const GAS bf16x8*)(WUK + (size_t)(32 * dt + q) * 128 + k), bf, ok[dt]); ov[dt] = mfma32(*(const GAS bf16x8*)(WUV + (size_t)(32 * dt + q) * 128 + k), bf, ov[dt]); } }
        ss = half_sum(ss); const float rc = 1.f / sqrtf(ss * (1.f / 128.f) + NORM_EPS);
        float s2 = 0.f;
#pragma unroll
        for (int dt = 0; dt < 2; ++dt)
#pragma unroll
            for (int r = 0; r < 16; ++r) { ok[dt][r] *= rc; ov[dt][r] *= rc; s2 += ok[dt][r] * ok[dt][r]; }
        s2 = half_sum(s2); const float rk = 1.f / sqrtf(s2 * (1.f / 64.f) + NORM_EPS);
        bf16* KBp = (bf16*)(ws + WS_KB) + tok * 64; bf16* VBp = (bf16*)(ws + WS_VB) + tok * 64;
#pragma unroll
        for (int dt = 0; dt < 2; ++dt)
#pragma unroll
            for (int gq = 0; gq < 4; ++gq) { const int d = 32 * dt + 8 * gq + 4 * hh; const f32x4 g4 = *(const GAS f32x4*)(gk + d);
                v2u w; w.x = pg8::cvt_pk_f16(ok[dt][4 * gq] * rk * g4.x, ok[dt][4 * gq + 1] * rk * g4.y); w.y = pg8::cvt_pk_f16(ok[dt][4 * gq + 2] * rk * g4.z, ok[dt][4 * gq + 3] * rk * g4.w);
                *(GAS v2u*)(KBp + d) = w;
                v2u v; v.x = pg8::cvt_pk_bf16(ov[dt][4 * gq], ov[dt][4 * gq + 1]); v.y = pg8::cvt_pk_bf16(ov[dt][4 * gq + 2], ov[dt][4 * gq + 3]);
                *(GAS v2u*)(VBp + d) = v; }
      } }
}

constexpr int NSA_KT = 0, NSA_VT = 18432, NSA_IMP = 36864, NSA_LUT = 69632, NSA_T2 = 77952  , NSA_TB = 9216;
struct NsaRegs { v4u k, v; };
__device__ __forceinline__ void nsa_issue(NsaRegs& R, const bf16* K, const bf16* V, size_t row0, int pitch, int coff, bool loadV, int tid) {
    const int key = tid >> 3, ch = tid & 7; const size_t off = (row0 + key) * pitch + coff + ch * 8;
    R.k = *(const GAS v4u*)(K + off); if (loadV) R.v = *(const GAS v4u*)(V + off);
}
__device__ __forceinline__ void nsa_commit(LAS unsigned char* lds, int buf, const NsaRegs& R, bool loadV, int tid) {
    const int key = tid >> 3, ch = tid & 7;
    *(LAS v4u*)(lds + NSA_KT + buf * NSA_TB + key * 144 + ch * 16) = R.k;
    if (loadV) *(LAS v4u*)(lds + NSA_VT + buf * NSA_TB + key * 144 + ch * 16) = R.v;
}
__device__ __forceinline__ void nsa_qk(f32x16& s0, f32x16& s1, const LAS unsigned char* kt, const bf16x8 (&qf)[4], int q, int hh) {
    s0 = zero16(); s1 = zero16();
#pragma unroll
    for (int s = 0; s < 4; ++s) { const bf16x8 a0 = *(const LAS bf16x8*)(kt + q * 144 + s * 32 + hh * 16); const bf16x8 a1 = *(const LAS bf16x8*)(kt + (32 + q) * 144 + s * 32 + hh * 16);
        s0 = mfma32h(a0, qf[s], s0); s1 = mfma32h(a1, qf[s], s1); }
}
template <int BR> __device__ __forceinline__ void nsa_mask_slow(f32x16& s, int kt, int hh, int tq, int base, bool lanesel, const LAS float* lutH, float farb) {
#pragma unroll
    for (int r = 0; r < 16; ++r) { const int key = 32 * kt + (r & 3) + 8 * (r >> 2) + 4 * hh; int rel; bool valid;
        if (BR == 0) { const int c = base + key; rel = tq - 16 * c - 31; valid = rel >= 0 && c < NCMP; }
        else if (BR == 1) { rel = tq - (base + key); valid = lanesel && rel >= 0; }
        else { rel = tq - (base + key); valid = rel >= 0 && rel < 512; }
        const int ri = rel < 0 ? 0 : (rel > 127 ? 127 : rel); const float bl = lutH[ri]; const float bias = rel < 128 ? bl : farb;
        s[r] = valid ? s[r] + bias : NEG_INF; }
}
__device__ __forceinline__ void nsa_mask_tab(f32x16& s, int kt, const LAS float* t2rel  ) {
#pragma unroll
    for (int r = 0; r < 16; ++r) s[r] += t2rel[-(32 * kt + (r & 3) + 8 * (r >> 2))];
}
__device__ __forceinline__ void nsa_mask_cmp(f32x16& s, int kt, int relc  , const LAS float* t2h  ) {
#pragma unroll
    for (int r = 0; r < 16; ++r) { int rel = relc - 16 * (32 * kt + (r & 3) + 8 * (r >> 2)); rel = rel < -1 ? -1 : (rel > 128 ? 128 : rel); s[r] += t2h[rel]; }
}
__device__ __forceinline__ void nsa_pv(const f32x16& s0, const f32x16& s1, f32x16& o0, f32x16& o1, const LAS unsigned char* vt, unsigned trb) {
#pragma unroll
    for (int kt = 0; kt < 2; ++kt)
#pragma unroll
        for (int s2 = 0; s2 < 2; ++s2) { const bf16x8 pb = pack8(kt ? s1 : s0, 8 * s2);
#pragma unroll
            for (int dt = 0; dt < 2; ++dt) { const LAS unsigned char* tp = vt + trb + (32 * kt + 16 * s2) * 144 + 64 * dt;
                const bf16x4 lo = __builtin_bit_cast(bf16x4, __builtin_amdgcn_ds_read_tr16_b64_v4i16((LAS v4i16_t*)tp)), hi = __builtin_bit_cast(bf16x4, __builtin_amdgcn_ds_read_tr16_b64_v4i16((LAS v4i16_t*)(tp + 8 * 144)));
                const bf16x8 va = (bf16x8){lo[0], lo[1], lo[2], lo[3], hi[0], hi[1], hi[2], hi[3]};
                if (dt == 0) o0 = mfma32(va, pb, o0); else o1 = mfma32(va, pb, o1); } }
}
__device__ __forceinline__ void nsa_softmax_pv(f32x16& s0, f32x16& s1, float cs, float& l, f32x16& o0, f32x16& o1, const LAS unsigned char* vt, unsigned trb) {
    const f32x2 c2 = (f32x2){cs, cs}; f32x2 acc2 = (f32x2){0.f, 0.f};
#pragma unroll
    for (int r = 0; r < 16; r += 2) { const f32x2 a = (f32x2){s0[r], s0[r + 1]} - c2, b = (f32x2){s1[r], s1[r + 1]} - c2;
        const f32x2 pa = (f32x2){fast_exp2(a.x), fast_exp2(a.y)}, pb = (f32x2){fast_exp2(b.x), fast_exp2(b.y)}; s0[r] = pa.x; s0[r + 1] = pa.y; s1[r] = pb.x; s1[r + 1] = pb.y; acc2 += pa + pb; }
    l += acc2.x + acc2.y;
    nsa_pv(s0, s1, o0, o1, vt, trb);
}

__device__ __forceinline__ void nsa_phase(Frame& F, const Args& A, const bool dry = false) {
    unsigned char* ws = F.ws; LAS unsigned char* lds = F.lds; int tid_ = F.tid; asm volatile("" : "+v"(tid_)); const int tid = tid_, lane = tid & 63;
    bf16* QA = (bf16*)(ws + WS_QA); const bf16* SK = (const bf16*)(ws + WS_SK); const bf16* SV = (const bf16*)(ws + WS_SV); const bf16* WK = (const bf16*)(ws + WS_WK); const bf16* WV = (const bf16*)(ws + WS_WV);
    const bf16* KC = (const bf16*)(ws + WS_KC); const bf16* VC = (const bf16*)(ws + WS_VC); const float* AG = (const float*)(ws + WS_AG);
    LAS float* lut = (LAS float*)(lds + NSA_LUT); LAS float* imp = (LAS float*)(lds + NSA_IMP);
    __syncthreads();
    { const float* lg = (const float*)(ws + WS_BIASLUT); for (int i = tid; i < 2066; i += NWAVES * 64) lut[i] = lg[i];
      LAS float* T2 = (LAS float*)(lds + NSA_T2); for (int i = tid; i < 8 * 640; i += NWAVES * 64) { const int h = i / 640, rel = i % 640 - 64; T2[i] = rel < 0 ? NEG_INF : (rel < 128 ? lg[h * 128 + rel] : (rel < 512 ? lg[2048 + h] : NEG_INF)); } }
    __syncthreads();
    for (int un = F.vcu; un < 2048; un += F.G) {
        int lane_o = lane; asm volatile("" : "+v"(lane_o));
        const int q = lane_o & 31, hh = lane_o >> 5, tl = q >> 2, hd = q & 3;
        int w_o = F.wave; asm volatile("" : "+s"(w_o)); const int w = w_o;
        const unsigned trb = (unsigned)(4 * hh + ((lane_o & 15) >> 2)) * 144u + (unsigned)(16 * ((lane_o >> 4) & 1) + 4 * (lane_o & 3)) * 2u;
        const int ix = (F.vcu & 31) + 32 * (un >> 8);
        const int kk = (ix >> 5) & 3, rr = ix & 31;
        const int qt = (F.G == 256) ? ((kk == 0) ? 127 - rr : (kk == 1) ? 64 + rr : (kk == 2) ? 63 - rr : rr) : 127 - (un >> 4), bg = (F.G == 256) ? 2 * (F.vcu >> 5) + (ix >> 7) : (un & 15), b = bg >> 1, g = bg & 1;
        const int t0 = qt * 64, tq = t0 + 8 * w + tl, head = 4 * g + hd; const size_t tokrow = (size_t)b * SEQ + tq;
        bf16x8 qf[4];
#pragma unroll
        for (int s = 0; s < 4; ++s) qf[s] = *(const GAS bf16x8*)(QA + tokrow * 512 + head * 64 + 16 * s + 8 * hh);
        const LAS float* lutH = lut + head * 128; const float farb = lut[2048 + head]; const LAS float* t2 = (const LAS float*)(lds + NSA_T2) + head * 640 + 64 - 4 * hh;
        const float g0 = AG[tokrow * 24 + head * 3 + 0], g1 = AG[tokrow * 24 + head * 3 + 1], g2 = AG[tokrow * 24 + head * 3 + 2];
#pragma unroll
        for (int i = 0; i < 16; ++i) imp[(8 * w) * 128 + i * 64 + lane] = 0.f;
        f32x16 of0 = zero16(), of1 = zero16();
        f32x16 s0, s1, o0, o1; float l; NsaRegs R; const float CSH = lut[2064];
        const int t1 = t0 + 63; const int nct = (t1 >= 31) ? ((((t1 - 31) >> 4) >> 6) + 1) : 0;
        const bf16* KCb = KC + (size_t)bg * 512 * 64; const bf16* VCb = VC + (size_t)bg * 512 * 64;
        l = 0.f;
        __syncthreads();
        if (nct > 0) nsa_issue(R, KCb, VCb, 0, 64, 0, false, tid);
        for (int ct = 0; ct < nct; ++ct) {
            const int buf = ct & 1; nsa_commit(lds, buf, R, false, tid); if (ct + 1 < nct) nsa_issue(R, KCb, VCb, (size_t)64 * (ct + 1), 64, 0, false, tid); __syncthreads();
            nsa_qk(s0, s1, lds + NSA_KT + buf * NSA_TB, qf, q, hh);
            const bool fast = (t0 + 8 * w) - (16 * (64 * ct + 63) + 31) >= 128; float cs = CSH;
            if (fast) cs = CSH - farb; else { const int relc = tq - 16 * (64 * ct + 4 * hh) - 31; nsa_mask_cmp(s0, 0, relc, t2 + 4 * hh); nsa_mask_cmp(s1, 1, relc, t2 + 4 * hh); }
            float ls = 0.f;
#pragma unroll
            for (int r = 0; r < 16; ++r) ls += fast_exp2(s0[r] - cs) + fast_exp2(s1[r] - cs);
            l += ls;
        }
        { const float lt = half_sum(l); const float inv = lt > 0.f ? 1.f / lt : 0.f;
          o0 = zero16(); o1 = zero16();
          __syncthreads();
          if (nct > 0) nsa_issue(R, KCb, VCb, 0, 64, 0, true, tid);
          for (int ct = 0; ct < nct; ++ct) {
            const int buf = ct & 1; nsa_commit(lds, buf, R, true, tid); if (ct + 1 < nct) nsa_issue(R, KCb, VCb, (size_t)64 * (ct + 1), 64, 0, true, tid); __syncthreads();
            nsa_qk(s0, s1, lds + NSA_KT + buf * NSA_TB, qf, q, hh);
            const bool fast = (t0 + 8 * w) - (16 * (64 * ct + 63) + 31) >= 128; float cs = CSH;
            if (fast) cs = CSH - farb; else { const int relc = tq - 16 * (64 * ct + 4 * hh) - 31; nsa_mask_cmp(s0, 0, relc, t2 + 4 * hh); nsa_mask_cmp(s1, 1, relc, t2 + 4 * hh); }
#pragma unroll
            for (int r = 0; r < 16; ++r) { s0[r] = fast_exp2(s0[r] - cs) * inv; s1[r] = fast_exp2(s1[r] - cs) * inv; }
#pragma unroll
            for (int kt = 0; kt < 2; ++kt)
#pragma unroll
                for (int gq = 0; gq < 4; ++gq) { const f32x16& p = kt ? s1 : s0; float a = (p[4 * gq] + p[4 * gq + 1]) + (p[4 * gq + 2] + p[4 * gq + 3]); float c3 = p[4 * gq + 3];
                    a += dpp_xor1(a); a += dpp_xor2(a); c3 += dpp_xor1(c3); c3 += dpp_xor2(c3);
                    const int jb = 16 * ct + 8 * kt + 2 * gq + hh;
                    if (hd == 0) { atomicAdd((float*)&imp[(8 * w + tl) * 128 + jb], a); if (jb + 1 < 128) atomicAdd((float*)&imp[(8 * w + tl) * 128 + jb + 1], c3); } }
            nsa_pv(s0, s1, o0, o1, lds + NSA_VT + buf * NSA_TB, trb);
          }
#pragma unroll
          for (int r = 0; r < 16; ++r) { of0[r] += g0 * o0[r]; of1[r] += g0 * o1[r]; }
        }
        LDS_WAIT();
        unsigned selw0 = 0u, selw1 = 0u, selw2 = 0u, selw3 = 0u;
        for (int i = 0; i < 8; ++i) {
            const int cur = qt; const int j0 = lane, j1 = lane + 64;
            const float v0 = imp[(8 * w + i) * 128 + j0], v1 = imp[(8 * w + i) * 128 + j1];
            const bool f0 = (j0 == 0) || (j0 == cur) || (j0 == cur - 1), f1 = (j1 == 0) || (j1 == cur) || (j1 == cur - 1);
            const float x0 = f0 ? 3.0e6f - (float)j0 : (j0 <= cur ? v0 : -1.0e6f - (float)j0), x1 = f1 ? 3.0e6f - (float)j1 : (j1 <= cur ? v1 : -1.0e6f - (float)j1);
            const unsigned k0 = ord_key(x0), k1 = ord_key(x1);
            unsigned pre = 0u;
            for (int bit = 31; bit >= 0; --bit) { const unsigned cand = pre | (1u << bit); const int cnt = __popcll(__ballot(k0 >= cand)) + __popcll(__ballot(k1 >= cand)); if (cnt >= 16) pre = cand; if (cnt == 16) break; }
            const unsigned long long mlo = __ballot(k0 >= pre), mhi = __ballot(k1 >= pre);
            if (tl == i) { selw0 = (unsigned)mlo; selw1 = (unsigned)(mlo >> 32); selw2 = (unsigned)mhi; selw3 = (unsigned)(mhi >> 32); }
        }
        l = 0.f; o0 = zero16(); o1 = zero16();
        __syncthreads();
        nsa_issue(R, SK, SV, (size_t)b * SEQ, 128, g * 64, true, tid);
        for (int j = 0; j <= qt; ++j) {
            const int buf = j & 1; nsa_commit(lds, buf, R, true, tid); if (j < qt) nsa_issue(R, SK, SV, (size_t)b * SEQ + 64 * (j + 1), 128, g * 64, true, tid); __syncthreads();
            const unsigned sw = (j < 32) ? selw0 : (j < 64) ? selw1 : (j < 96) ? selw2 : selw3; const bool lanesel = (sw >> (j & 31)) & 1u;
            if (!__any(lanesel)) continue;
            nsa_qk(s0, s1, lds + NSA_KT + buf * NSA_TB, qf, q, hh);
            float cs = CSH;
            if (j >= qt - 2) { const LAS float* tr = t2 + (lanesel ? tq - 64 * j : 4 * hh - 1); nsa_mask_tab(s0, 0, tr); nsa_mask_tab(s1, 1, tr); } else cs = lanesel ? CSH - farb : -NEG_INF;
            nsa_softmax_pv(s0, s1, cs, l, o0, o1, lds + NSA_VT + buf * NSA_TB, trb);
        }
        { const float lt = half_sum(l); const float sc = lt > 0.f ? g1 / lt : 0.f;
#pragma unroll
          for (int r = 0; r < 16; ++r) { of0[r] += sc * o0[r]; of1[r] += sc * o1[r]; } }
        l = 0.f; o0 = zero16(); o1 = zero16();
        { const int jf = qt > 8 ? qt - 8 : 0;
          __syncthreads();
          nsa_issue(R, WK, WV, (size_t)b * SEQ + 64 * jf, 128, g * 64, true, tid);
          for (int j = jf; j <= qt; ++j) {
            const int buf = j & 1; nsa_commit(lds, buf, R, true, tid); if (j < qt) nsa_issue(R, WK, WV, (size_t)b * SEQ + 64 * (j + 1), 128, g * 64, true, tid); __syncthreads();
            nsa_qk(s0, s1, lds + NSA_KT + buf * NSA_TB, qf, q, hh);
            float cs = CSH;
            if (j >= qt - 2 || j == qt - 8) { const LAS float* tr = t2 + (tq - 64 * j); nsa_mask_tab(s0, 0, tr); nsa_mask_tab(s1, 1, tr); } else cs = CSH - farb;
            nsa_softmax_pv(s0, s1, cs, l, o0, o1, lds + NSA_VT + buf * NSA_TB, trb);
          } }
        { const float lt = half_sum(l); const float sc = lt > 0.f ? g2 / lt : 0.f;
#pragma unroll
          for (int r = 0; r < 16; ++r) { of0[r] += sc * o0[r]; of1[r] += sc * o1[r]; } }
        bf16* op = QA + tokrow * 512 + head * 64;
        if (!dry)
#pragma unroll
        for (int gq = 0; gq < 4; ++gq) { v2u a; a.x = pg8::cvt_pk_bf16(of0[4 * gq], of0[4 * gq + 1]); a.y = pg8::cvt_pk_bf16(of0[4 * gq + 2], of0[4 * gq + 3]); *(GAS v2u*)(op + 8 * gq + 4 * hh) = a;
            v2u c; c.x = pg8::cvt_pk_bf16(of1[4 * gq], of1[4 * gq + 1]); c.y = pg8::cvt_pk_bf16(of1[4 * gq + 2], of1[4 * gq + 3]); *(GAS v2u*)(op + 32 + 8 * gq + 4 * hh) = c; }
    }
    __syncthreads();
}

constexpr int DS_PML = 0, DS_SELIDX = 4096, DS_CTRL = 8192, DS_WCNT = 8320, DS_EQ = 8448, DS_EQV = 10496, DS_PO = 12544  , DS_DUMMY = 28928  , DS_VT = 31744, DS_HIST = 31744  , DS_LUT = 115712;
__device__ __forceinline__ int dsa_scan32(int v) {
    v += __builtin_amdgcn_update_dpp(0, v, 0x111, 0xf, 0xf, false); v += __builtin_amdgcn_update_dpp(0, v, 0x112, 0xf, 0xf, false);
    v += __builtin_amdgcn_update_dpp(0, v, 0x114, 0xf, 0xf, false); v += __builtin_amdgcn_update_dpp(0, v, 0x118, 0xf, 0xf, false);
    v += __builtin_amdgcn_update_dpp(0, v, 0x142, 0xa, 0xf, false); return v; }
__device__ __forceinline__ int dsa_scan64(int v) { v = dsa_scan32(v); v += __builtin_amdgcn_update_dpp(0, v, 0x143, 0xc, 0xf, false); return v; }
__device__ __forceinline__ int dsa_key(float f) { const int k = (int)fmaf(f, 134217728.0f, 1073741824.0f); return k < 1 ? 1 : k; }
__device__ __forceinline__ void dsa_phase(Frame& F, const Args& A, const int dry = 0) {
    unsigned char* ws = F.ws; LAS unsigned char* lds = F.lds; int tid_ = F.tid; asm volatile("" : "+v"(tid_)); const int tid = tid_, lane = tid & 63;
    const bf16* IQ = (const bf16*)(ws + WS_IQ); const bf16* IK = (const bf16*)(ws + WS_IK); const float* IW = (const float*)(ws + WS_IW);
    bf16* QB = (bf16*)(ws + WS_QB); const bf16* KB = (const bf16*)(ws + WS_KB); const bf16* VB = (const bf16*)(ws + WS_VB);
    LAS int* hist = (LAS int*)(lds + DS_HIST); LAS int* selidx = (LAS int*)(lds + DS_SELIDX); LAS int* ctrl = (LAS int*)(lds + DS_CTRL); LAS int* eql = (LAS int*)(lds + DS_HIST); LAS int* eqk = (LAS int*)(lds + DS_HIST + 16384)    ;
    LAS int* wcnt = (LAS int*)(lds + DS_WCNT); LAS float* pml = (LAS float*)(lds + DS_PML); LAS float* po = (LAS float*)(lds + DS_PO); LAS float* lut = (LAS float*)(lds + DS_LUT);
    __syncthreads();
    { const float* lg = (const float*)(ws + WS_BIASLUT); for (int i = tid; i < 2066; i += NWAVES * 64) lut[i] = lg[i]; }
    __syncthreads();
    for (int un = F.vcu; un < NTOK / 4; un += F.G) {
        int lane_o = lane, tid_o = tid_; asm volatile("" : "+v"(lane_o), "+v"(tid_o));
        const int q = lane_o & 31, hh = lane_o >> 5; const int tid = tid_o;
        int w_o = F.wave; asm volatile("" : "+s"(w_o)); const int w = w_o;
        LAS unsigned char* vtb = lds + DS_VT + w * 10496;
        const int b = (F.G == 256) ? (F.vcu >> 5) : (un & 7), t0 = (F.G == 256) ? 4 * (2047 - ((F.vcu & 31) + 32 * (un >> 8))) : 4 * (2047 - (un >> 3)), tmax = t0 + 3; const size_t brow = (size_t)b * SEQ;
        bf16x8 af[4];
#pragma unroll
        for (int s = 0; s < 4; ++s) af[s] = *(const GAS bf16x8*)(IQ + (brow + t0 + (((q >> 2) & 1) * 2 + (q >> 4))) * 512 + (((q >> 3) & 1) * 4 + (q & 3)) * 64 + 16 * s + 8 * hh);
        float wv[16];
#pragma unroll
        for (int t = 0; t < 4; ++t) { const f32x4 w4 = *(const GAS f32x4*)(IW + (brow + t0 + 2 * hh + (t >> 1)) * 8 + 4 * (t & 1)); wv[4 * t] = w4.x; wv[4 * t + 1] = w4.y; wv[4 * t + 2] = w4.z; wv[4 * t + 3] = w4.w; }
        int kq = 32 * w + q; asm volatile("" : "+v"(kq));
        const int nit = ((tmax >> 5) >= w) ? ((((tmax >> 5) - w) >> 3) + 1) : 0;
        int sk[32][2];
        bf16x8 bb[2][4];
        const bf16* pl = IK + ((((size_t)b * 256 + w) * 4) * 2 + hh) * 256 + q * 8;
        const int rot = (nit * (F.vcu & 31)) >> 5; int tl_ = rot;
        pl += (size_t)rot * (8 * 2048);
#define DSA_LOADB(IT, ADV) do { if (ADV) { const bool wrap_ = (tl_ + 1 == nit); pl = wrap_ ? pl - (size_t)(nit - 1) * (8 * 2048) : pl + 8 * 2048; tl_ = wrap_ ? 0 : tl_ + 1; } asm volatile("" : "+v"(pl)); _Pragma("unroll") for (int s = 0; s < 4; ++s) bb[(IT) & 1][s] = *(const GAS bf16x8*)(pl + 512 * s); } while (0)
        if (nit > 0) DSA_LOADB(0, false);
        int tc_ = rot;
#pragma unroll
        for (int it = 0; it < 32; ++it) {
            if (it < nit) {
                if (it + 1 < 32) DSA_LOADB(it + 1, it + 1 < nit);
                f32x16 acc = zero16();
#pragma unroll
                for (int s = 0; s < 4; ++s) acc = mfma32h(af[s], bb[it & 1][s], acc);
                float ps[2];
#pragma unroll
                for (int t = 0; t < 2; ++t) { f32x2 a2 = (f32x2){relu_i(acc[8 * t]), relu_i(acc[8 * t + 1])} * (f32x2){wv[8 * t], wv[8 * t + 1]};
#pragma unroll
                    for (int j = 1; j < 4; ++j) a2 = (f32x2){relu_i(acc[8 * t + 2 * j]), relu_i(acc[8 * t + 2 * j + 1])} * (f32x2){wv[8 * t + 2 * j], wv[8 * t + 2 * j + 1]} + a2;
                    ps[t] = a2.x + a2.y; }
                int k0 = dsa_key(ps[0]), k1 = dsa_key(ps[1]);
                if (tc_ == nit - 1) { asm volatile("" ::: "memory");     const int key = kq + 256 * tc_; k0 = key <= t0 + 2 * hh ? k0 : 0; k1 = key <= t0 + 2 * hh + 1 ? k1 : 0; }
                tc_ = (tc_ + 1 == nit) ? 0 : tc_ + 1;
                sk[it][0] = k0; sk[it][1] = k1;
            } else { sk[it][0] = 0; sk[it][1] = 0; }
            asm volatile("" ::: "memory");
        }
#undef DSA_LOADB
        if (dry == 2) { int acc_ = 0;
#pragma unroll
            for (int it = 0; it < 32; ++it) acc_ += sk[it][0] + sk[it][1];
            if (acc_ == 12345678) pml[lane] = 1.f; __syncthreads(); continue; }
        const bool selall = tmax <= 255;
        if (tid < 4) { ctrl[tid * 8 + 0] = 0; ctrl[tid * 8 + 1] = 256; ctrl[tid * 8 + 2] = 0; ctrl[tid * 8 + 3] = 0; }
        if (!selall) {
#pragma unroll
            for (int i = 0; i < 4; ++i) *(LAS v4u*)(lds + DS_HIST + (i * 512 + tid) * 16) = (v4u){0u, 0u, 0u, 0u}; }
        __syncthreads();
        if (!selall) {
            LAS int* h0 = hist + (2 * hh) * 2048; LAS int* h1 = h0 + 2048; int nitp = nit; asm volatile("" : "+s"(nitp));
#pragma unroll
            for (int it = 0; it < 32; ++it) { if (it < nitp) { atomicAdd((int*)&h0[sk[it][0] >> 20], 1); atomicAdd((int*)&h1[sk[it][1] >> 20], 1); } __builtin_amdgcn_sched_barrier(0); }
            __syncthreads();
            if (w < 4) { const int T = w; const int need = 256; const LAS v4u* hp = (const LAS v4u*)(hist + T * 2048 + 32 * lane);
                int tot = 0;
#pragma unroll
                for (int j = 0; j < 8; ++j) { const v4u c = hp[j]; tot += (int)(c.x + c.y + c.z + c.w); }
                const int pre = dsa_scan64(tot); const int suf = __builtin_amdgcn_readlane(pre, 63) - pre + tot;
                const int L = __popcll(__ballot(suf >= need)) - 1;
                { int acc = suf - tot; int dig = 0, nn = need; bool found = false;
#pragma unroll
                  for (int j = 7; j >= 0; --j) { const v4u c = hp[j]; const int cc[4] = {(int)c.x, (int)c.y, (int)c.z, (int)c.w};
#pragma unroll
                      for (int e = 3; e >= 0; --e) { const bool cross = !found && (acc + cc[e] >= need); dig = cross ? 4 * j + e : dig; nn = cross ? need - acc : nn; found = found || cross; acc += cc[e]; } }
                  if (lane == L) { ctrl[T * 8 + 0] = 32 * lane + dig; ctrl[T * 8 + 1] = nn; } } }
            __syncthreads();
        }
        int idxbase = kq; asm volatile("" : "+v"(idxbase));
        const int th0 = selall ? -1 : ctrl[(2 * hh) * 8 + 0], th1 = selall ? -1 : ctrl[(2 * hh + 1) * 8 + 0];
        const int thr0 = selall ? 0 : (int)((((unsigned)th0 + 1u) << 20) - 1u), thr1 = selall ? 0 : (int)((((unsigned)th1 + 1u) << 20) - 1u);
        int lp0, lp1;
        { int n0 = 0, n1 = 0; int nitc = nit; asm volatile("" : "+s"(nitc));
#pragma unroll
          for (int it = 0; it < 32; ++it) { if (it < nitc) { n0 += sk[it][0] > thr0 ? 1 : 0; n1 += sk[it][1] > thr1 ? 1 : 0; } }
          const int i0 = dsa_scan32(n0), i1 = dsa_scan32(n1);
          lp0 = i0 - n0; lp1 = i1 - n1;
          if (q == 31) { wcnt[w * 4 + 2 * hh] = i0; wcnt[w * 4 + 2 * hh + 1] = i1; } }
        __syncthreads();
        int tot0 = 0, tot1 = 0, tot2 = 0, tot3 = 0, bs0 = 0, bs1 = 0, bs2 = 0, bs3 = 0;
#pragma unroll
        for (int ww = 0; ww < 8; ++ww) { const int a0 = wcnt[ww * 4 + 0], a1 = wcnt[ww * 4 + 1], a2 = wcnt[ww * 4 + 2], a3 = wcnt[ww * 4 + 3];
            tot0 += a0; tot1 += a1; tot2 += a2; tot3 += a3; if (ww < w) { bs0 += a0; bs1 += a1; bs2 += a2; bs3 += a3; } }
        { int thr0b = thr0, thr1b = thr1; asm volatile("" : "+v"(thr0b), "+v"(thr1b));
          const int tl0 = selall ? 0x7fffffff : ((th0 << 20) - 1 < 0 ? 0 : (th0 << 20) - 1), tl1 = selall ? 0x7fffffff : ((th1 << 20) - 1 < 0 ? 0 : (th1 << 20) - 1);
          LAS int* dummy = (LAS int*)(lds + DS_DUMMY) + tid;
          int run0 = (hh ? bs2 : bs0) + lp0, run1 = (hh ? bs3 : bs1) + lp1; int nite = nit; asm volatile("" : "+s"(nite));
          LAS int* sel0 = selidx + (2 * hh) * 256; LAS int* sel1 = selidx + (2 * hh + 1) * 256;
          int te_ = rot; asm volatile("" : "+s"(te_));
#pragma unroll
          for (int it = 0; it < 32; ++it) { if (it < nite) { const int idx = idxbase + 256 * te_; te_ = (te_ + 1 == nite) ? 0 : te_ + 1; const int k0 = sk[it][0], k1 = sk[it][1];
              const bool s0 = k0 > thr0b, s1 = k1 > thr1b;
              { LAS int* d0 = (s0 && run0 < 256) ? sel0 + run0 : dummy; LAS int* d1 = (s1 && run1 < 256) ? sel1 + run1 : dummy; *d0 = idx; *d1 = idx; }
              run0 += s0 ? 1 : 0; run1 += s1 ? 1 : 0;
              const bool e0 = !s0 && k0 > tl0, e1 = !s1 && k1 > tl1;
              if (__any(e0 || e1)) {
              if (e0) { const int p = atomicAdd((int*)&ctrl[(2 * hh) * 8 + 3], 1); if (p < 1024) { eql[(2 * hh) * 1024 + p] = idx; eqk[(2 * hh) * 1024 + p] = k0; } }
              if (e1) { const int p = atomicAdd((int*)&ctrl[(2 * hh + 1) * 8 + 3], 1); if (p < 1024) { eql[(2 * hh + 1) * 1024 + p] = idx; eqk[(2 * hh + 1) * 1024 + p] = k1; } } } }
              __builtin_amdgcn_sched_barrier(0); } }
        __syncthreads();
        if (w < 4) { const int T = w; const int totT = (T == 0) ? tot0 : (T == 1) ? tot1 : (T == 2) ? tot2 : tot3;
            if (!selall) { int ne = ctrl[T * 8 + 3]; ne = ne > 1024 ? 1024 : ne; const int need = ctrl[T * 8 + 1];
                for (int me = lane; me < ne; me += 64) { const int mine = eql[T * 1024 + me]; const int mv = eqk[T * 1024 + me]; int rank = 0;
                    for (int j = 0; j < ne; ++j) { const int vj = eqk[T * 1024 + j]; const int ij = eql[T * 1024 + j]; rank += (vj > mv || (vj == mv && ij < mine)) ? 1 : 0; }
                    if (rank < need && totT + rank < 256) selidx[T * 256 + totT + rank] = mine; }
                if (lane == 0) { const int nn = totT + (need < ne ? need : ne); ctrl[T * 8 + 2] = nn; } }
            else if (lane == 0) ctrl[T * 8 + 2] = totT; }
        __syncthreads();
        if (dry == 3) { __syncthreads(); continue; }
        { int lane_a = lane_o, t0_a = t0; asm volatile("" : "+v"(lane_a), "+s"(t0_a));
          const int q = lane_a & 31, hh = lane_a >> 5;
          const int T = w >> 1, hs = w & 1, tokq = t0_a + T; int n = ctrl[T * 8 + 2]; n = n > 256 ? 256 : n;
          const unsigned traddr = (unsigned)(8 * hh + ((lane_a & 15) >> 2)) * 144u + (unsigned)(16 * ((lane_a >> 4) & 1) + 4 * (lane_a & 3)) * 2u;
          v4u onesw; onesw.x = onesw.y = onesw.z = onesw.w = (q == 0) ? 0x3f803f80u : 0u; const bf16x8 onesf = __builtin_bit_cast(bf16x8, onesw);
          int ridx[4];
#pragma unroll
          for (int c = 0; c < 4; ++c) { const int slot = 128 * hs + 32 * c + q; ridx[c] = slot < n ? selidx[T * 256 + slot] : 0; }
          unsigned go[4][4];
#pragma unroll
          for (int c = 0; c < 4; ++c) {
#pragma unroll
              for (int i = 0; i < 4; ++i) { const int slot = 128 * hs + 32 * c + 8 * i + (lane_a >> 3); const int row = slot < n ? selidx[T * 256 + slot] : 0;
                  go[c][i] = (unsigned)row * 128u + (unsigned)((((lane_a & 7) ^ (4 * (i & 1) + (lane_a >> 4))) & 7) << 4); } }
          LAS unsigned char* kt = vtb; LAS unsigned char* vt = vtb + 4096; LAS unsigned short* ptw = (LAS unsigned short*)(vtb + 8192);
          const unsigned ktu = (unsigned)(size_t)kt, vtu = (unsigned)(size_t)vt;
          const char* kbase = (const char*)(KB + brow * 64); const char* vbase = (const char*)(VB + brow * 64);
          const int rr = (lane_a & 15) >> 2;
          unsigned tra[2][2];
#pragma unroll
          for (int nt = 0; nt < 2; ++nt) {
#pragma unroll
              for (int hi = 0; hi < 2; ++hi) { const int R0 = 8 * hh + rr + 4 * hi; const int seg = ((nt ^ hh) << 2) | ((((lane_a >> 4) & 1) ^ hi) << 1) | (((lane_a & 3) >> 1) ^ (rr >> 1));
                  tra[nt][hi] = (unsigned)(R0 * 128 + seg * 16 + 8 * (lane_a & 1)); } }
          unsigned kad[4];
#pragma unroll
          for (int ks = 0; ks < 4; ++ks) kad[ks] = (unsigned)(q * 128 + (((2 * ks + hh) ^ ((q >> 1) & 7)) << 4));
          bf16x8 qf[4];
#pragma unroll
          for (int ks = 0; ks < 4; ++ks) qf[ks] = *(const GAS bf16x8*)(QB + (brow + tokq) * 512 + (q & 7) * 64 + 16 * ks + 8 * hh);
#define DSA_GK(C) do { _Pragma("unroll") for (int i = 0; i < 4; ++i) pg8::glds16_s(kbase, go[C][i], ktu + (unsigned)(i * 1024)); } while (0)
#define DSA_GV(C) do { _Pragma("unroll") for (int i = 0; i < 4; ++i) pg8::glds16_s(vbase, go[C][i], vtu + (unsigned)(i * 1024)); } while (0)
          DSA_GK(0); DSA_GV(0);
          f32x16 o0 = zero16(), o1 = zero16(), o2 = zero16(); const float CSH = lut[2065];
          const float bfar0 = lut[2048 + 8 + 4 * hh], bfar1 = lut[2048 + 9 + 4 * hh], bfar2 = lut[2048 + 10 + 4 * hh], bfar3 = lut[2048 + 11 + 4 * hh];
#pragma unroll
          for (int c = 0; c < 4; ++c) {
              asm volatile("s_waitcnt vmcnt(0)" ::: "memory");
              bf16x8 kf[4], vb[2][2];
#pragma unroll
              for (int ks = 0; ks < 4; ++ks) kf[ks] = *(const LAS bf16x8*)(kt + kad[ks]);
#pragma unroll
              for (int s2 = 0; s2 < 2; ++s2) {
#pragma unroll
                  for (int nt = 0; nt < 2; ++nt) {
                      const bf16x4 lo = __builtin_bit_cast(bf16x4, __builtin_amdgcn_ds_read_tr16_b64_v4i16((LAS v4i16_t*)(vt + tra[nt][0] + s2 * 2048))), hi = __builtin_bit_cast(bf16x4, __builtin_amdgcn_ds_read_tr16_b64_v4i16((LAS v4i16_t*)(vt + tra[nt][1] + s2 * 2048)));
                      vb[s2][nt] = (bf16x8){lo[0], lo[1], lo[2], lo[3], hi[0], hi[1], hi[2], hi[3]}; } }
              LDS_WAIT();
              if (c < 3) { DSA_GK(c + 1); DSA_GV(c + 1); }
              f32x16 sc4 = zero16();
#pragma unroll
              for (int ks = 0; ks < 4; ++ks) sc4 = mfma32h(qf[ks], kf[ks], sc4);
              const int rel = tokq - ridx[c]; const bool valid = (128 * hs + 32 * c + q < n) && rel >= 0; const int ri = rel < 0 ? 0 : (rel > 127 ? 127 : rel);
              float sv[4];
              { const LAS float* lp = lut + (8 + 4 * hh) * 128 + ri; const bool nr = rel < 128;
                sv[0] = valid ? sc4[0] + (nr ? lp[0] : bfar0) : NEG_INF; sv[1] = valid ? sc4[1] + (nr ? lp[128] : bfar1) : NEG_INF; sv[2] = valid ? sc4[2] + (nr ? lp[256] : bfar2) : NEG_INF; sv[3] = valid ? sc4[3] + (nr ? lp[384] : bfar3) : NEG_INF; }
#pragma unroll
              for (int r = 0; r < 4; ++r) { const float p = fast_exp2(sv[r] - CSH); ptw[(4 * hh + r) * 40 + q] = (unsigned short)(pg8::cvt_pk_bf16(p, p) & 0xffffu); }
              LDS_WAIT();
              bf16x8 pa[2];
#pragma unroll
              for (int s2 = 0; s2 < 2; ++s2) { v4u z; z.x = z.y = z.z = z.w = 0u; pa[s2] = (q < 8) ? *(const LAS bf16x8*)(ptw + q * 40 + 16 * s2 + 8 * hh) : __builtin_bit_cast(bf16x8, z); }
#pragma unroll
              for (int s2 = 0; s2 < 2; ++s2) { o0 = mfma32(pa[s2], vb[s2][0], o0); o1 = mfma32(pa[s2], vb[s2][1], o1); o2 = mfma32(pa[s2], onesf, o2); }
          }
#undef DSA_GK
#undef DSA_GV
          { LAS float* op = po + (size_t)((T * 2 + hs) * 8 + 4 * hh) * 64 + q;
#pragma unroll
            for (int r = 0; r < 4; ++r) { op[r * 64] = o0[r]; op[r * 64 + 32] = o1[r]; }
            if (q == 0) {
#pragma unroll
                for (int r = 0; r < 4; ++r) { pml[((T * 2 + hs) * 8 + 4 * hh + r) * 2] = 0.f; pml[((T * 2 + hs) * 8 + 4 * hh + r) * 2 + 1] = o2[r]; } } } }
        __syncthreads();
        { const int T = tid >> 7, hd = (tid >> 4) & 7, d4 = (tid & 15) * 4;
          const float L = pml[((T * 2) * 8 + hd) * 2 + 1] + pml[((T * 2 + 1) * 8 + hd) * 2 + 1];
          const f32x4 O = *(const LAS f32x4*)(po + (size_t)((T * 2) * 8 + hd) * 64 + d4) + *(const LAS f32x4*)(po + (size_t)((T * 2 + 1) * 8 + hd) * 64 + d4);
          const float inv = L > 0.f ? 1.f / L : 0.f; v2u o; o.x = pg8::cvt_pk_bf16(O.x * inv, O.y * inv); o.y = pg8::cvt_pk_bf16(O.z * inv, O.w * inv);
          if (!dry) *(GAS v2u*)(QB + (brow + t0 + T) * 512 + hd * 64 + d4) = o; }
        __syncthreads();
    }
    __syncthreads();
}

constexpr int NPH = 12;
#ifndef MK_ONE_LAUNCH
#define MK_ONE_LAUNCH 0
#endif
#ifndef TEST_STAGE
#define TEST_STAGE 0
#endif

#define INP_ARG(i) (args.in[(i)])
template <int PHM, int MODE = 0> __global__ void __launch_bounds__(NWAVES * 64, 2) fwd(Args args) {
    extern __shared__ __attribute__((aligned(16))) unsigned char lds[];
    Frame F;
    F.lds = (LAS unsigned char*)lds;
    F.tid = threadIdx.x; F.lane = F.tid & 63; F.wave = __builtin_amdgcn_readfirstlane(F.tid >> 6);
    F.G = gridDim.x; { const int bx = blockIdx.x; F.vcu = (F.G % 8 == 0) ? (bx % 8) * (F.G / 8) + bx / 8 : bx; }
    F.ws = args.ws; F.ctl = (gu32*)(args.ws + WS_CTL); F.out = args.out; F.in = nullptr;
    unsigned char* ws = args.ws;
    volatile LAS unsigned* MISC = (volatile LAS unsigned*)(F.lds + MISC_OFF);
    for (int u = F.tid; u < (LDS_BYTES - LDSCTL_OFF) / 4; u += NWAVES * 64) ((LAS unsigned*)(F.lds + LDSCTL_OFF))[u] = 0u;
    if (F.tid < 29) ((LAS unsigned long long*)(F.lds + PTR_OFF))[F.tid] = (unsigned long long)INP_ARG(F.tid);
    __syncthreads();
    const int lo = args.ph_lo, hi = args.ph_hi;
    XcdBarrier bar; bar.bar = (unsigned*)(F.ctl + CW_BAR); bar.x = 0; bar.st = nullptr;
    if (hi - lo > 1) bar = xcd_barrier_post((unsigned*)(F.ctl + CW_BAR), MISC + 8);
#ifndef PH_MASK
#define PH_MASK 0xFFFF
#endif
#define IN(k) ((((PH_MASK & PHM) >> (k)) & 1) && lo <= (k) && (k) < hi)
#define BOTH(k) (IN(k) && IN((k) + 1))
#ifndef DUP_MASK
#define DUP_MASK 0
#endif
#define ARG_MODE MODE
#ifndef PROBE_PH
#define PROBE_PH -1
#endif
#ifndef PROBE_MODE
#define PROBE_MODE 1
#endif
#ifdef PROBE_DUP
#define NREP(k) (1 + ((args.dup >> (k)) & 1))
#else
#define NREP(k) 1
#endif
#define GRID_BAR() xcd_barrier(bar)

    if (IN(0)) { p0_prologue(F, args); if (BOTH(0)) GRID_BAR(); }

#if TEST_STAGE != 1
    if (IN(1)) {
        pg8::Gemm g{(const bf16*)(ws + WS_XN), (const bf16*)(ws + WS_WIN), NTOK, NPIN, DM}; pg8::StaticOrder S; S.init(NTOK, NPIN, F.G, (int)blockIdx.x);
        pg8::EpiInProj E{ws, INP(3), INP(16), INP(4)};
        pg8::gemm_phase<pg8::EpiInProj, pg8::StaticOrder, 1024, true, false>(F.lds + RING_OFF, g, S, E);
        if (BOTH(1)) GRID_BAR();
    }
    if (IN(2)) { small_phase(F, args); if (BOTH(2)) GRID_BAR(); }
    if (IN(3)) { nsa_phase(F, args, ARG_MODE != 0); }
    if (IN(4)) { dsa_phase(F, args, ARG_MODE); if (BOTH(4)) GRID_BAR(); }
    if (IN(5)) { {
        { pg8::Gemm g{(const bf16*)(ws + WS_QA), (const bf16*)(ws + WS_WA), NTOK, DM, 512}; pg8::StaticOrder S; S.init(NTOK, DM, F.G, (int)blockIdx.x);
          pg8::EpiMerge<0> E{(const bf16*)(ws + WS_GA), (bf16*)(ws + WS_XN)};
          pg8::gemm_phase<pg8::EpiMerge<0>, pg8::StaticOrder, 512, true, false>(F.lds + RING_OFF, g, S, E); }
        { pg8::Gemm g{(const bf16*)(ws + WS_QB), (const bf16*)(ws + WS_WB), NTOK, DM, 512}; pg8::StaticOrder S; S.init(NTOK, DM, F.G, (int)blockIdx.x);
          pg8::EpiMerge<1> E{(const bf16*)(ws + WS_GB), (bf16*)(ws + WS_XN)};
          pg8::gemm_phase<pg8::EpiMerge<1>, pg8::StaticOrder, 512, true, false>(F.lds + RING_OFF, g, S, E); } }
        if (BOTH(5)) GRID_BAR();
    }
    if (IN(6)) {
        pg8::Gemm g{(const bf16*)(ws + WS_XN), (const bf16*)(ws + WS_WO), NTOK, DM, DM}; pg8::StaticOrder S; S.init(NTOK, DM, F.G, (int)blockIdx.x);
        pg8::EpiOut E{INP(0), args.out};
        pg8::gemm_phase<pg8::EpiOut, pg8::StaticOrder, 1024, true, false>(F.lds + RING_OFF, g, S, E);
        if (BOTH(6)) GRID_BAR();
    }
#else
    if (IN(6)) {
        const f32x4* src = (const f32x4*)INP(0); f32x4* dst = (f32x4*)args.out;
        for (size_t i = (size_t)blockIdx.x * (NWAVES * 64) + F.tid; i < (size_t)NTOK * DM / 4; i += (size_t)F.G * NWAVES * 64) dst[i] = src[i];
        if (BOTH(6)) GRID_BAR();
    }
#endif
    if (IN(7)) { router_phase(F, args, ARG_MODE != 0); if (BOTH(7)) GRID_BAR(); }
    if (IN(8)) { dispatch_phase(F); if (BOTH(8)) GRID_BAR(); }
    if (IN(9)) {
        const int T = __builtin_amdgcn_readfirstlane(((const int*)(ws + WS_TILEE))[2048]);
        LAS int* te = (LAS int*)(F.lds + RING_BYTES + 9216); __syncthreads(); for (int i = F.tid; i < T; i += NWAVES * 64) te[i] = ((const int*)(ws + WS_TILEE))[i]; __syncthreads();
        pg8::Gemm g{(const bf16*)(ws + WS_XN), (const bf16*)(ws + WS_W1T), T * 256, 2048, DM}; pg8::MoeOrder S; S.init(T, 8, F.G, (int)blockIdx.x, te);
        pg8::EpiSwiglu E{(bf16*)(ws + WS_ACT), INP(26)};
        pg8::gemm_phase<pg8::EpiSwiglu, pg8::MoeOrder, 1024, true, true>(F.lds + RING_OFF, g, S, E, (const int*)(ws + WS_ROWTOK));
        if (BOTH(9)) GRID_BAR();
    }
    if (IN(10)) {
        const int T = __builtin_amdgcn_readfirstlane(((const int*)(ws + WS_TILEE))[2048]);
        LAS int* te = (LAS int*)(F.lds + RING_BYTES + 9216); __syncthreads(); for (int i = F.tid; i < T; i += NWAVES * 64) te[i] = ((const int*)(ws + WS_TILEE))[i]; __syncthreads();
        pg8::Gemm g{(const bf16*)(ws + WS_ACT), (const bf16*)(ws + WS_W2T), T * 256, 1024, DEXP}; pg8::MoeRowOrder S; S.init(T, 4, F.G, (int)blockIdx.x, te);
        pg8::EpiDown E{(bf16*)(ws + WS_XN), (bf16*)(ws + WS_ACT), (bf16*)(ws + WS_YX), INP(28), (const float*)(ws + WS_ROWGATE), (T / 256) * 256, ARG_MODE != 0};
        pg8::gemm_phase<pg8::EpiDown, pg8::MoeRowOrder, 1024, true, false>(F.lds + RING_OFF, g, S, E);
        if (BOTH(10)) GRID_BAR();
    }
    if (IN(11)) { combine_phase(F, ARG_MODE != 0); }
#undef IN
#undef BOTH
#undef GRID_BAR
}

extern "C" void kernel_launch(void* const* d_in, const int* in_sizes, int n_in, void* d_out, int out_size, void* d_ws, size_t ws_size, hipStream_t stream) {
    static int grid = 0;
    if (grid == 0) {
        if (n_in != 29 || in_sizes[0] != NTOK * DM || out_size != NTOK * DM || ws_size < WS_END) { fprintf(stderr, "kernel_launch: unexpected shapes (n_in %d, in0 %d, out %d, ws %zu); nothing launched\n", n_in, n_in > 0 ? in_sizes[0] : -1, out_size, ws_size); grid = -1; return; }
        int dev = 0, cus = 0;
        if (hipGetDevice(&dev) != hipSuccess || hipDeviceGetAttribute(&cus, hipDeviceAttributeMultiprocessorCount, dev) != hipSuccess) { grid = -1; return; }
        grid = cus;
        if (grid != 256) { fprintf(stderr, "kernel_launch: built for 256 CUs (got %d)\n", grid); grid = -1; return; }
    }
    if (grid < 0) return;
    if (hipMemsetAsync((char*)d_ws + WS_CTL, 0, CTL_ZERO_BYTES, stream) != hipSuccess) return;
    Args a{};
    for (int i = 0; i < 29; ++i) a.in[i] = (const float*)d_in[i];
    a.out = (float*)d_out; a.ws = (unsigned char*)d_ws;
#define LAUNCH(MASK, LO, HI) do { static bool attr_set = false; if (!attr_set) { (void)hipFuncSetAttribute((const void*)fwd<MASK>, hipFuncAttributeMaxDynamicSharedMemorySize, LDS_BYTES); attr_set = true; } \
        a.ph_lo = (LO); a.ph_hi = (HI); hipLaunchKernelGGL(fwd<MASK>, dim3(grid), dim3(NWAVES * 64), LDS_BYTES, stream, a); } while (0)
#if MK_ONE_LAUNCH
    LAUNCH(0xFFF, 0, NPH);
#else
#define PL(MASK, P) do { LAUNCH(MASK, P, (P) + 1); if (PROBE_PH == (P)) { static bool as2 = false; if (!as2) { (void)hipFuncSetAttribute((const void*)fwd<MASK, PROBE_MODE>, hipFuncAttributeMaxDynamicSharedMemorySize, LDS_BYTES); as2 = true; } a.ph_lo = (P); a.ph_hi = (P) + 1; hipLaunchKernelGGL((fwd<MASK, PROBE_MODE>), dim3(grid), dim3(NWAVES * 64), LDS_BYTES, stream, a); } } while (0)
    PL(0x001, 0); PL(0x002, 1); PL(0x004, 2); PL(0x008, 3); PL(0x010, 4); PL(0x020, 5); PL(0x040, 6); PL(0x080, 7); PL(0x100, 8); PL(0x200, 9); PL(0x400, 10); PL(0x800, 11);
#undef PL
#endif
#undef LAUNCH
}
```

```cpp
#define MK_ONE_LAUNCH 1
#include <hip/hip_runtime.h>
#include <cstdio>
#include <cstdint>

#define GAS __attribute__((address_space(1)))
#define LAS __attribute__((address_space(3)))
typedef unsigned short bf16;
typedef unsigned v4u __attribute__((ext_vector_type(4)));
typedef unsigned v2u __attribute__((ext_vector_type(2)));
typedef float f32x4 __attribute__((ext_vector_type(4)));
typedef float f32x16 __attribute__((ext_vector_type(16)));
typedef short bf16x8 __attribute__((ext_vector_type(8)));
typedef short bf16x4 __attribute__((ext_vector_type(4)));
typedef short v4i16_t __attribute__((ext_vector_type(4)));
typedef GAS unsigned gu32;

constexpr int NB = 8, SEQ = 8192, DM = 1024, NTOK = NB * SEQ;
constexpr int DIN = 4576, NPIN = 4608;
constexpr int NEXP = 32, TOPK = 4, DEXP = 1024;
constexpr int MAXTILES = NTOK * TOPK / 256 + NEXP;
constexpr float NORM_EPS = 1e-6f;
constexpr float LOG2E = 1.4426950408889634f;
constexpr float QSCALE = 0.125f * LOG2E;
constexpr int NCMP = 511, NCMPP = 512;
constexpr int NWAVES = 8;

constexpr size_t MiB = 1u << 20;
constexpr size_t WS_CTL = 0, CTL_ZERO_BYTES = 1 * MiB;
constexpr size_t WS_BIASLUT = 1 * MiB;
constexpr size_t WS_TILEE = 1 * MiB + 64 * 1024;
constexpr size_t WS_WRP = 1 * MiB + 256 * 1024;
constexpr size_t WS_GAINS = 1 * MiB + 512 * 1024;
constexpr size_t WS_CW1K = 2 * MiB, WS_CW1V = 2 * MiB + 512 * 1024;
constexpr size_t WS_CW2K = 3 * MiB, WS_CW2V = 3 * MiB + 16 * 1024;
constexpr size_t WS_WUK = 3 * MiB + 32 * 1024, WS_WUV = 3 * MiB + 48 * 1024;
constexpr size_t WS_CB1K = 3 * MiB + 64 * 1024, WS_CB1V = 3 * MiB + 65 * 1024;
constexpr size_t WS_KC = 4 * MiB, WS_VC = 5 * MiB;
constexpr size_t WS_TOKE = 6 * MiB, WS_TOKG = 7 * MiB, WS_TOKP = 8 * MiB;
constexpr size_t WS_ROWTOK = 9 * MiB, WS_ROWGATE = 10 * MiB + 512 * 1024;
constexpr size_t WS_IW = 12 * MiB, WS_AG = 14 * MiB;
constexpr size_t WS_WIN = 20 * MiB;
constexpr size_t WS_WA = 29 * MiB, WS_WB = 30 * MiB, WS_WO = 31 * MiB;
constexpr size_t WS_W1T = 33 * MiB, WS_W2T = 161 * MiB;
constexpr size_t WS_XN = 225 * MiB;
constexpr size_t WS_QA = 353 * MiB, WS_QB = 417 * MiB, WS_IQ = 481 * MiB, WS_GA = 545 * MiB, WS_GB = 673 * MiB;
constexpr size_t WS_SK = 801 * MiB, WS_WK = 817 * MiB, WS_CK = 833 * MiB, WS_CV = 849 * MiB, WS_SV = 865 * MiB, WS_WV = 881 * MiB;
constexpr size_t WS_CKV = 897 * MiB, WS_IK = 913 * MiB, WS_KB = 921 * MiB, WS_VB = 929 * MiB, WS_END = 960 * MiB;
constexpr size_t WS_YX = 940 * MiB;
constexpr size_t WS_ACT = 353 * MiB;
static_assert(WS_ACT + (size_t)MAXTILES * 256 * 1024 * 2 <= WS_END, "ACT overlay");
constexpr int CW_TMO = 0, CW_CODE = 1;
constexpr int CW_BAR = 4096;
constexpr int CW_CNT = 16384;

constexpr int RING_OFF = 0, RING_BYTES = 131072;
constexpr int LDSCTL_OFF = RING_BYTES, MISC_OFF = LDSCTL_OFF + 320;
constexpr int LDS_BYTES = 147456;

#define RLX_AGENT __ATOMIC_RELAXED, __HIP_MEMORY_SCOPE_AGENT
#define LDS_WAIT() asm volatile("s_waitcnt lgkmcnt(0)" ::: "memory")
#define VM_WAIT() asm volatile("s_waitcnt vmcnt(0)" ::: "memory")
__device__ __forceinline__ unsigned f2bf(float f) { unsigned u = __builtin_bit_cast(unsigned, f); return (u + 0x7fffu + ((u >> 16) & 1u)) >> 16; }
__device__ __forceinline__ unsigned pk2(float lo, float hi) { return f2bf(lo) | (f2bf(hi) << 16); }
__device__ __forceinline__ float bf2f(unsigned short h) { return __builtin_bit_cast(float, (unsigned)h << 16); }
__device__ __forceinline__ float bflo(unsigned w) { return __builtin_bit_cast(float, w << 16); }
__device__ __forceinline__ float bfhi(unsigned w) { return __builtin_bit_cast(float, w & 0xffff0000u); }
__device__ __forceinline__ float fast_exp2(float x) { return __builtin_amdgcn_exp2f(x); }
__device__ __forceinline__ float fast_rcp(float x) { return __builtin_amdgcn_rcpf(x); }
__device__ __forceinline__ float sigmoidf_(float x) { return fast_rcp(1.f + fast_exp2(-x * LOG2E)); }

__device__ __forceinline__ int tid_now(int wave) { unsigned z = 0u; asm volatile("" : "+v"(z)); return wave * 64 + (int)__builtin_amdgcn_mbcnt_hi(~0u, __builtin_amdgcn_mbcnt_lo(~0u, z)); }
__device__ const unsigned char REL_BUCKET[128] = {0,1,2,3,4,5,6,7,8,9,10,11,12,13,14,15,16,16,16,17,17,18,18,18,19,19,19,20,20,20,20,21,21,21,21,22,22,22,22,22,23,23,23,23,23,23,24,24,24,24,24,24,25,25,25,25,25,25,25,26,26,26,26,26,26,26,26,27,27,27,27,27,27,27,27,27,27,28,28,28,28,28,28,28,28,28,28,29,29,29,29,29,29,29,29,29,29,29,29,30,30,30,30,30,30,30,30,30,30,30,30,30,30,31,31,31,31,31,31,31,31,31,31,31,31,31,31,31};
namespace pg8 {
#define PG8_LAS __attribute__((address_space(3)))
#define PG8_GAS __attribute__((address_space(1)))
typedef unsigned short bf16_t;
typedef short bf16x8 __attribute__((ext_vector_type(8)));
typedef float f32x4 __attribute__((ext_vector_type(4)));
typedef unsigned u32x4 __attribute__((ext_vector_type(4)));
typedef unsigned u32x2 __attribute__((ext_vector_type(2)));
constexpr int BM = 256, BK = 64, HALF = 128, HTB = HALF * BK * 2  , STAGE_BYTES = 8 * HTB, NXCD = 8, WGM = 8;

__host__ __device__ __forceinline__ int lds_byte(int r, int c) { const int st = (r >> 4) * 2 + (c >> 5), rr = r & 15, cc = c & 31, ob = rr * 64 + cc * 2; return st * 1024 + (ob ^ (((ob >> 9) & 1) << 5)); }
__host__ __device__ __forceinline__ void stage_rc(int b, int& R, int& C) { const int st = b / 1024, sb = b % 1024, swz = sb ^ (((sb >> 9) & 1) << 5); R = (st >> 1) * 16 + swz / 64; C = (st & 1) * 32 + (swz % 64) / 2; }
__host__ __device__ __forceinline__ int perm32(int rho) { const int n = rho >> 4, i = rho & 15; return 8 * (i >> 2) + 4 * n + (i & 3); }

struct Unit { int pm, pn, pb; };
struct Gemm { const bf16_t* A; const bf16_t* Bt; int M, N, K; };

struct StaticOrder {
    int nM, nN, nwg, G, c;
    __host__ __device__ void init(int M, int N, int G_, int c_) { nM = M / BM; nN = N / BM; nwg = nM * nN; G = G_; c = c_; }
    __host__ __device__ bool next(int i, Unit& u) const {
        const long L = (long)i * G + c; if (L >= nwg) return false;
        int wgid = (int)L; { const int q = nwg / NXCD, r = nwg % NXCD, xcd = wgid % NXCD, off = wgid / NXCD; wgid = (xcd < r ? xcd * (q + 1) : r * (q + 1) + (xcd - r) * q) + off; }
        const int nig = WGM * nN, gid = wgid / nig, fm = gid * WGM, gsz = (nM - fm) < WGM ? (nM - fm) : WGM;
        u.pm = fm + ((wgid % nig) % gsz); u.pn = (wgid % nig) / gsz; u.pb = u.pn; return true;
    }
};
struct MoeOrder {
    int nM, nN, nwg, G, c; const PG8_LAS int* tile_e;
    __device__ void init(int T, int nN_, int G_, int c_, const PG8_LAS int* te) { nM = T; nN = nN_; nwg = nM * nN; G = G_; c = c_; tile_e = te; }
    __device__ bool next(int i, Unit& u) const {
        const long L = (long)i * G + c; if (L >= nwg) return false;
        int wgid = (int)L; { const int q = nwg / NXCD, r = nwg % NXCD, xcd = wgid % NXCD, off = wgid / NXCD; wgid = (xcd < r ? xcd * (q + 1) : r * (q + 1) + (xcd - r) * q) + off; }
        const int nig = WGM * nN, gid = wgid / nig, fm = gid * WGM, gsz = (nM - fm) < WGM ? (nM - fm) : WGM;
        u.pm = fm + ((wgid % nig) % gsz); u.pn = (wgid % nig) / gsz;
        const int e = __builtin_amdgcn_readfirstlane(tile_e[u.pm]); u.pb = e * nN + u.pn; return true;
    }
};

__device__ __forceinline__ void glds16_s(const void* sbase, unsigned voff, unsigned lds_dst) { unsigned keep;
    asm volatile("s_mov_b32 %0, m0\n\ts_mov_b32 m0, %3\n\ts_nop 0\n\tglobal_load_lds_dwordx4 %2, %1\n\ts_mov_b32 m0, %0" : "=&s"(keep) : "s"(sbase), "v"(voff), "s"(lds_dst) : "memory"); }
struct MoeRowOrder {
    int nM, nN, G, c; const PG8_LAS int* tile_e;
    __device__ void init(int T, int nN_, int G_, int c_, const PG8_LAS int* te) { nM = T; nN = nN_; G = G_; c = c_; tile_e = te; }
    __device__ bool next(int i, Unit& u) const {
        const int rfull = nM / G, nfull = rfull * nN;
        if (i < nfull) { const int round = i / nN; u.pn = i - round * nN; u.pm = round * G + c; }
        else { const int L = c + G * (i - nfull); if (L >= (nM - rfull * G) * nN) return false; u.pm = rfull * G + L / nN; u.pn = L % nN; }
        const int e = __builtin_amdgcn_readfirstlane(tile_e[u.pm]); u.pb = e * nN + u.pn; return true;
    }
};
__device__ __forceinline__ unsigned cvt_pk_bf16(float lo, float hi) { unsigned r; asm volatile("v_cvt_pk_bf16_f32 %0, %1, %2" : "=v"(r) : "v"(lo), "v"(hi)); return r; }

template <class Epi, class Sched, int KC, bool ALIGN_EPI = false, bool GATHER = false>
__device__ __forceinline__ void gemm_phase(PG8_LAS unsigned char* lds, const Gemm g, const Sched& S, const Epi& E, const int* rowtab = nullptr) {
    int tid_ = threadIdx.x; asm volatile("" : "+v"(tid_));
    const int tid = tid_, wid = __builtin_amdgcn_readfirstlane(tid >> 6), lane = tid & 63, wr = wid >> 2, wc = wid & 3, fr = lane & 15, fq = lane >> 4;
    constexpr int K = KC, nt = K / BK; static_assert(KC % 128 == 0 && KC >= 256, "K");
    unsigned voffA[2], voffB[2];
#pragma unroll
    for (int i = 0; i < 2; ++i) { int R, C; stage_rc(tid * 16 + i * 8192, R, C); const int Rb = Epi::PERM ? ((R & ~31) + perm32(R & 31)) : R;
        voffA[i] = (unsigned)(R * K + C) * 2u; voffB[i] = (unsigned)(Rb * K + C) * 2u; }
    const size_t kstep = (size_t)(BK * 2);
    const size_t hstep = (size_t)HALF * K * 2;
    const size_t tstep = 2 * hstep;
    const unsigned ldsw = (unsigned)wid * 1024u; const unsigned ldsu = (unsigned)(size_t)lds;
    const int aoff = lds_byte(wr * 64 + fr, fq * 8), boff = lds_byte(wc * 32 + fr, fq * 8);
#define PG8_SA(b, h) (((b) * 2 + (h)) * HTB)
#define PG8_SB(b, h) ((4 + (b) * 2 + (h)) * HTB)
#define PG8_STAGE(bufoff, gbase, voff) do { _Pragma("unroll") for (int _i = 0; _i < 2; ++_i) \
        glds16_s((const void*)((const char*)(gbase)), (voff)[_i], ldsu + (unsigned)(bufoff) + ldsw + (unsigned)(_i * 8192)); } while (0)
#define PG8_STAGE_A(bufoff, h, pA, kb, NEXT) do { if constexpr (GATHER) { PG8_STAGE(bufoff, (const char*)g.A + (kb), gC[h]); } else { PG8_STAGE(bufoff, (pA) + (size_t)(h) * hstep + (kb), voffA); } } while (0)
#define PG8_LDA(dst, b, h) do { _Pragma("unroll") for (int m = 0; m < 4; ++m) _Pragma("unroll") for (int k = 0; k < 2; ++k) dst[m][k] = *(const PG8_LAS bf16x8*)(lds + PG8_SA(b, h) + aoff + m * 2048 + k * 1024); } while (0)
#define PG8_LDB(dst, b, h) do { _Pragma("unroll") for (int n = 0; n < 2; ++n) _Pragma("unroll") for (int k = 0; k < 2; ++k) dst[n][k] = *(const PG8_LAS bf16x8*)(lds + PG8_SB(b, h) + boff + n * 2048 + k * 1024); } while (0)
#define PG8_MMA(ai, bj, At, Bt) do { __builtin_amdgcn_s_setprio(1); _Pragma("unroll") for (int m = 0; m < 4; ++m) _Pragma("unroll") for (int n = 0; n < 2; ++n) _Pragma("unroll") for (int k = 0; k < 2; ++k) \
        acc[ai][bj][m][n] = __builtin_amdgcn_mfma_f32_16x16x32_bf16(Bt[n][k], At[m][k], acc[ai][bj][m][n], 0, 0, 0); __builtin_amdgcn_s_setprio(0); } while (0)
#define PG8_WAIT_V(n) asm volatile("s_waitcnt vmcnt(" #n ")" ::: "memory")
#define PG8_WAIT_L(n) asm volatile("s_waitcnt lgkmcnt(" #n ")" ::: "memory")
#define PG8_BAR __builtin_amdgcn_s_barrier()
#define PG8_SCHED __builtin_amdgcn_sched_barrier(0)
    Unit cur, nxt; int ui = 0;
    if (!S.next(0, cur)) return;
    f32x4 acc[2][2][4][2];
#pragma unroll
    for (int a = 0; a < 2; ++a)
#pragma unroll
        for (int b = 0; b < 2; ++b)
#pragma unroll
            for (int m = 0; m < 4; ++m)
#pragma unroll
                for (int n = 0; n < 2; ++n) acc[a][b][m][n] = (f32x4){0.f, 0.f, 0.f, 0.f};
    bf16x8 At[4][2], B0[2][2], B1[2][2];
    unsigned gC[2][2] = {{0u, 0u}, {0u, 0u}}; PG8_LAS unsigned* park = (PG8_LAS unsigned*)(lds + STAGE_BYTES + 1024);
    if constexpr (GATHER) {
#pragma unroll
        for (int h = 0; h < 2; ++h)
#pragma unroll
            for (int i = 0; i < 2; ++i) { int R, C; stage_rc(tid * 16 + i * 8192, R, C); int t = rowtab[cur.pm * BM + h * HALF + R]; t = t < 0 ? 0 : t; gC[h][i] = (unsigned)t * (unsigned)(K * 2) + (unsigned)(C * 2); }
    }
    int gR[2][2] = {{0, 0}, {0, 0}};
    if constexpr (GATHER) { Unit n1; const int pm1 = S.next(1, n1) ? n1.pm : cur.pm;
#pragma unroll
        for (int h = 0; h < 2; ++h)
#pragma unroll
            for (int i = 0; i < 2; ++i) { int R, C; stage_rc(tid * 16 + i * 8192, R, C); gR[h][i] = rowtab[pm1 * BM + h * HALF + R]; } }
    const char* cA = (const char*)g.A + (GATHER ? (size_t)0 : (size_t)cur.pm * tstep); const char* cB = (const char*)g.Bt + (size_t)cur.pb * tstep;
    PG8_STAGE(PG8_SB(0, 0), cB, voffB); PG8_STAGE(PG8_SB(0, 1), cB + hstep, voffB); PG8_STAGE_A(PG8_SA(0, 0), 0, cA, (size_t)0, false); PG8_STAGE_A(PG8_SA(0, 1), 1, cA, (size_t)0, false);
    if (wr == 1) PG8_BAR;
    PG8_WAIT_V(2); PG8_BAR;
    PG8_STAGE(PG8_SB(1, 0), cB + kstep, voffB); PG8_STAGE_A(PG8_SA(1, 0), 0, cA, kstep, false); PG8_STAGE(PG8_SB(1, 1), cB + hstep + kstep, voffB);
    PG8_WAIT_V(6); PG8_BAR;
    for (;;) {
        const bool has_next = S.next(ui + 1, nxt);
        if constexpr (GATHER) {
#pragma unroll
            for (int h = 0; h < 2; ++h)
#pragma unroll
                for (int i = 0; i < 2; ++i) { int R, C; stage_rc(tid * 16 + i * 8192, R, C); int t = gR[h][i]; t = t < 0 ? 0 : t; park[(h * 2 + i) * 512 + tid] = (unsigned)t * (unsigned)(K * 2) + (unsigned)(C * 2); }
            Unit n2; const bool has2 = has_next && S.next(ui + 2, n2); const int pm2 = has2 ? n2.pm : (has_next ? nxt.pm : cur.pm);
#pragma unroll
            for (int h = 0; h < 2; ++h)
#pragma unroll
                for (int i = 0; i < 2; ++i) { int R, C; stage_rc(tid * 16 + i * 8192, R, C); gR[h][i] = rowtab[pm2 * BM + h * HALF + R]; }
        }
        const char* nA = GATHER ? cA : (has_next ? (const char*)g.A + (size_t)nxt.pm * tstep : cA); const char* nB = has_next ? (const char*)g.Bt + (size_t)nxt.pb * tstep : cB;
#define PG8_ITER(LASTF) do { \
            const size_t k1 = (size_t)(t + 1) * kstep; \
            const size_t k2 = (LASTF) ? (size_t)0 : (size_t)(t + 2) * kstep; \
            const size_t k3 = k2 + kstep; \
            const char* a2 = (LASTF) ? nA : cA; const char* b2 = ((LASTF) ? nB : cB) + k2; const char* b3 = b2 + kstep; \
            PG8_LDB(B0, 0, 0); PG8_LDB(B1, 0, 1); PG8_SCHED; PG8_LDA(At, 0, 0); PG8_STAGE_A(PG8_SA(1, 1), 1, cA, k1, false); \
            if constexpr (GATHER && (LASTF)) { _Pragma("unroll") for (int _h = 0; _h < 2; ++_h) _Pragma("unroll") for (int _i = 0; _i < 2; ++_i) gC[_h][_i] = park[(_h * 2 + _i) * 512 + tid]; } \
            PG8_WAIT_V(8); PG8_WAIT_L(0); PG8_BAR; PG8_MMA(0, 0, At, B0); PG8_MMA(0, 1, At, B1); PG8_BAR; PG8_SCHED; \
            PG8_LDA(At, 0, 1); PG8_STAGE(PG8_SB(0, 0), b2, voffB); PG8_STAGE(PG8_SB(0, 1), b2 + hstep, voffB); PG8_STAGE_A(PG8_SA(0, 0), 0, a2, k2, LASTF); \
            PG8_WAIT_V(8); PG8_WAIT_L(0); PG8_BAR; PG8_MMA(1, 0, At, B0); PG8_MMA(1, 1, At, B1); PG8_BAR; PG8_SCHED; \
            PG8_LDB(B0, 1, 0); PG8_LDB(B1, 1, 1); PG8_SCHED; PG8_LDA(At, 1, 0); PG8_STAGE_A(PG8_SA(0, 1), 1, a2, k2, LASTF); \
            PG8_WAIT_V(8); PG8_WAIT_L(0); PG8_BAR; PG8_MMA(0, 0, At, B0); PG8_MMA(0, 1, At, B1); PG8_BAR; PG8_SCHED; \
            PG8_LDA(At, 1, 1); PG8_STAGE(PG8_SB(1, 0), b3, voffB); PG8_STAGE(PG8_SB(1, 1), b3 + hstep, voffB); PG8_STAGE_A(PG8_SA(1, 0), 0, a2, k3, LASTF); \
            PG8_WAIT_V(8); PG8_WAIT_L(0); PG8_BAR; PG8_MMA(1, 0, At, B0); PG8_MMA(1, 1, At, B1); PG8_BAR; PG8_SCHED; } while (0)
        { int t = 0;
          for (; t < nt - 2; t += 2) PG8_ITER(false);
          PG8_ITER(true); }
#undef PG8_ITER
        if constexpr (ALIGN_EPI) { if (wr == 0) PG8_BAR; }
        E(acc, cur, wr, wc, fr, fq);
        if (!has_next) break;
#pragma unroll
        for (int a = 0; a < 2; ++a)
#pragma unroll
            for (int b = 0; b < 2; ++b)
#pragma unroll
                for (int m = 0; m < 4; ++m)
#pragma unroll
                    for (int n = 0; n < 2; ++n) acc[a][b][m][n] = (f32x4){0.f, 0.f, 0.f, 0.f};
        cur = nxt; cA = nA; cB = nB; ++ui;
        if constexpr (ALIGN_EPI) { if (wr == 1) PG8_BAR; }
    }
    PG8_WAIT_V(0);
    if constexpr (!ALIGN_EPI) { if (wr == 0) PG8_BAR; }
    PG8_BAR;
#undef PG8_SA
#undef PG8_SB
#undef PG8_STAGE
#undef PG8_STAGE_A
#undef PG8_LDA
#undef PG8_LDB
#undef PG8_MMA
#undef PG8_WAIT_V
#undef PG8_WAIT_L
#undef PG8_BAR
#undef PG8_SCHED
}
}

#define XB_TMO      128
#define XB_XCNT(j)  (256  + 64 * (j))
#define XB_XSUB(j)  (1280 + 64 * (j))
#define XB_XGEN(j)  (2304 + 64 * (j))
#define XB_TOP      3328
#define XB_TOPGEN   3392
#define XCD_BAR_WORDS 3456
#define XB_SPIN_CAP (1u << 18)

__device__ __forceinline__ unsigned xb_ld(unsigned* p)              { return __hip_atomic_load(p, __ATOMIC_RELAXED, __HIP_MEMORY_SCOPE_AGENT); }
__device__ __forceinline__ unsigned xb_add(unsigned* p, unsigned v) { return __hip_atomic_fetch_add(p, v, __ATOMIC_RELAXED, __HIP_MEMORY_SCOPE_AGENT); }
__device__ __forceinline__ unsigned xb_xcc_id() { return (unsigned)__builtin_amdgcn_s_getreg((3 << 11) | 20) & 0xFu; }
#define XB_SPIN(cond, bar) do { unsigned _sp = 0; while (cond) { __builtin_amdgcn_s_sleep(1); \
    if ((++_sp & 255u) == 0u) { if (xb_ld(&(bar)[XB_TMO])) break; if (_sp > XB_SPIN_CAP) { atomicAdd(&(bar)[XB_TMO], 1u); break; } } } } while (0)

struct XcdBarrier {
    unsigned* bar; unsigned x;
    volatile LAS unsigned* st;
};
__device__ __forceinline__ XcdBarrier xcd_barrier_post(unsigned* bar, volatile LAS unsigned* st) {
    XcdBarrier b; b.bar = bar; b.x = xb_xcc_id(); b.st = st;
    if (threadIdx.x == 0) (void)xb_add(&bar[XB_XCNT(b.x)], 1u);
    return b;
}
__device__ __forceinline__ void xcd_barrier_complete(unsigned* bar, unsigned x, unsigned& nloc, unsigned& nx) {
    const unsigned G = gridDim.x * gridDim.y * gridDim.z;
    unsigned sum, cnt, mine, sp = 0u;
    for (;;) {
        sum = 0u; cnt = 0u; mine = 0u;
#pragma unroll
        for (unsigned j = 0; j < 16; ++j) { const unsigned c = xb_ld(&bar[XB_XCNT(j)]); sum += c; cnt += (c > 0u) ? 1u : 0u; mine = (j == x) ? c : mine; }
        if (sum == G) break;
        __builtin_amdgcn_s_sleep(1);
        if ((++sp & 255u) == 0u) { if (xb_ld(&bar[XB_TMO])) break; if (sp > XB_SPIN_CAP) { atomicAdd(&bar[XB_TMO], 1u); break; } }
    }
    nloc = mine > 0u ? mine : 1u; nx = cnt > 0u ? cnt : 1u;
}
__device__ __forceinline__ void xcd_barrier(const XcdBarrier& b) {
    asm volatile("s_waitcnt vmcnt(0)" ::: "memory");
    __syncthreads();
    if (threadIdx.x == 0) {
        unsigned* bar = b.bar;
        __builtin_amdgcn_s_waitcnt(0);
        unsigned nloc = b.st[0], nx = b.st[1];
        if (nloc == 0u) { xcd_barrier_complete(bar, b.x, nloc, nx); b.st[0] = nloc; b.st[1] = nx; }
        const unsigned old = xb_add(&bar[XB_XSUB(b.x)], 1u);
        const unsigned gen = old / nloc;
        if (old + 1u == (gen + 1u) * nloc) {
            __builtin_amdgcn_fence(__ATOMIC_RELEASE, "agent");
            asm volatile("s_waitcnt vmcnt(0)" ::: "memory");
            const unsigned og = xb_add(&bar[XB_TOP], 1u);
            const unsigned tg = og / nx;
            if (og + 1u == (tg + 1u) * nx) xb_add(&bar[XB_TOPGEN], 1u);
            else XB_SPIN(xb_ld(&bar[XB_TOPGEN]) == tg, bar);
            __builtin_amdgcn_fence(__ATOMIC_ACQUIRE, "agent");
            xb_add(&bar[XB_XGEN(b.x)], 1u);
            asm volatile("s_waitcnt vmcnt(0)" ::: "memory");
        } else {
            XB_SPIN(xb_ld(&bar[XB_XGEN(b.x)]) == gen, bar);
            __builtin_amdgcn_fence(__ATOMIC_ACQUIRE, "agent");
            asm volatile("s_waitcnt vmcnt(0)" ::: "memory");
        }
    }
    __syncthreads();
}

struct Frame {
    LAS unsigned char* lds;
    unsigned char* ws;
    gu32* ctl;
    int tid, lane, wave;
    int vcu, G;
    const float* const* in;
    float* out;
};
constexpr int PTR_OFF = LDSCTL_OFF + 512;
__device__ __forceinline__ const float* inptr(LAS unsigned char* lds, int i) { const unsigned long long v = ((const LAS unsigned long long*)(lds + PTR_OFF))[i];
    return (const float*)(((unsigned long long)(unsigned)__builtin_amdgcn_readfirstlane((int)(unsigned)(v >> 32)) << 32) | (unsigned long long)(unsigned)__builtin_amdgcn_readfirstlane((int)(unsigned)v)); }
#define INP(i) inptr(F.lds, (i))
__device__ __forceinline__ float wave_sum(float v) {
#pragma unroll
    for (int o = 1; o < 64; o <<= 1) v += __shfl_xor(v, o);
    return v;
}

namespace pg8 {
__device__ __forceinline__ unsigned cvt_pk_f16(float lo, float hi) { typedef _Float16 h2 __attribute__((ext_vector_type(2))); h2 v = (h2){(_Float16)lo, (_Float16)hi}; return __builtin_bit_cast(unsigned, v); }
struct EpiInProj {
    static constexpr bool PERM = true;
    unsigned char* ws; const float* gq_a; const float* gq_b; const float* gk;
    __device__ __forceinline__ void operator()(const f32x4 (&acc)[2][2][4][2], const Unit& u, int wr, int wc, int fr_in, int fq_in) const {
        int fr = fr_in, fq = fq_in; asm volatile("" : "+v"(fr), "+v"(fq));
        const int pn = u.pn;
        int kind = 0; size_t dst = 0; int pitch = 512, cofs = 0; const float* gain = nullptr; float post = 1.f;
        if (pn < 2)       { kind = 1; dst = WS_QA; pitch = 512; cofs = (pn * 4 + wc) * 64; gain = gq_a; post = QSCALE; }
        else if (pn < 4)  { kind = 1; dst = WS_QB; pitch = 512; cofs = ((pn - 2) * 4 + wc) * 64; gain = gq_b; post = QSCALE; }
        else if (pn == 4) { kind = 1; dst = (wc < 2) ? WS_SK : WS_WK; pitch = 128; cofs = (wc & 1) * 64; gain = gk; }
        else if (pn == 5) { kind = 0; dst = (wc < 2) ? WS_CK : WS_CV; pitch = 128; cofs = (wc & 1) * 64; }
        else if (pn == 6) { kind = 0; dst = (wc < 2) ? WS_SV : WS_WV; pitch = 128; cofs = (wc & 1) * 64; }
        else if (pn < 9)  { kind = 5; dst = WS_IQ; pitch = 512; cofs = ((pn - 7) * 4 + wc) * 64; }
        else if (pn == 9) { if (wc < 2) { kind = 0; dst = WS_CKV; pitch = 128; cofs = wc * 64; } else if (wc == 2) { kind = 4; } else kind = 3; }
        else if (pn < 14) { kind = 2; dst = WS_GA; pitch = 1024; cofs = (pn - 10) * 256 + wc * 64; }
        else              { kind = 2; dst = WS_GB; pitch = 1024; cofs = (pn - 14) * 256 + wc * 64; }
        const int row0 = u.pm * BM + wr * 64 + fr;
        if (kind == 3) {
            float* IW = (float*)(ws + WS_IW); float* AG = (float*)(ws + WS_AG);
#pragma unroll
            for (int ai = 0; ai < 2; ++ai)
#pragma unroll
                for (int m = 0; m < 4; ++m) { const int row = row0 + ai * HALF + m * 16; const f32x4 v0 = acc[ai][0][m][0], v1 = acc[ai][0][m][1];
                    if (fq == 0) { const float s = 0.125f * 0.35355339059327373f; *(f32x4*)(IW + (size_t)row * 8) = v0 * s; *(f32x4*)(IW + (size_t)row * 8 + 4) = v1 * s; }
                    else { f32x4 a, b;
#pragma unroll
                        for (int i = 0; i < 4; ++i) { a[i] = sigmoidf_(v0[i]); b[i] = sigmoidf_(v1[i]); }
                        *(f32x4*)(AG + (size_t)row * 24 + (fq - 1) * 8) = a; *(f32x4*)(AG + (size_t)row * 24 + (fq - 1) * 8 + 4) = b; } }
            return;
        }
        if (kind == 4) {
            bf16_t* IKT = (bf16_t*)(ws + WS_IK);
#pragma unroll
            for (int ai = 0; ai < 2; ++ai)
#pragma unroll
                for (int m = 0; m < 4; ++m) { const int row = row0 + ai * HALF + m * 16; const int tb = row >> 5, within = row & 31;
#pragma unroll
                    for (int bj = 0; bj < 2; ++bj) { const f32x4 v0 = acc[ai][bj][m][0], v1 = acc[ai][bj][m][1]; const int sidx = 2 * bj + (fq >> 1);
                        u32x4 w; w.x = cvt_pk_f16(v0[0], v0[1]); w.y = cvt_pk_f16(v0[2], v0[3]); w.z = cvt_pk_f16(v1[0], v1[1]); w.w = cvt_pk_f16(v1[2], v1[3]);
                        *(u32x4*)(IKT + ((((size_t)tb * 4 + sidx) * 2 + (fq & 1)) * 32 + within) * 8) = w; } }
            return;
        }
        bf16_t* base = (bf16_t*)(ws + dst) + cofs + 8 * fq;
        f32x4 gv[2][2];
#pragma unroll
        for (int bj = 0; bj < 2; ++bj) { gv[bj][0] = (f32x4){1.f, 1.f, 1.f, 1.f}; gv[bj][1] = gv[bj][0]; if (kind == 1) { gv[bj][0] = *(const PG8_GAS f32x4*)((const PG8_GAS float*)gain + 32 * bj + 8 * fq); gv[bj][1] = *(const PG8_GAS f32x4*)((const PG8_GAS float*)gain + 32 * bj + 8 * fq + 4); } }
#pragma unroll
        for (int ai = 0; ai < 2; ++ai)
#pragma unroll
            for (int m = 0; m < 4; ++m) { bf16_t* rowp = base + (size_t)(row0 + ai * HALF + m * 16) * pitch;
                float r = 1.f;
                if (kind == 1) {
                    float ss = 0.f;
#pragma unroll
                    for (int bj = 0; bj < 2; ++bj)
#pragma unroll
                        for (int n = 0; n < 2; ++n) { const f32x4 x = acc[ai][bj][m][n]; ss += (x[0] * x[0] + x[1] * x[1]) + (x[2] * x[2] + x[3] * x[3]); }
                    ss += __shfl_xor(ss, 16); ss += __shfl_xor(ss, 32);
                    r = post / sqrtf(ss * (1.0f / 64.0f) + NORM_EPS);
                }
#pragma unroll
                for (int bj = 0; bj < 2; ++bj) { f32x4 v0 = acc[ai][bj][m][0], v1 = acc[ai][bj][m][1];
                    if (kind == 1) { v0 = v0 * r * gv[bj][0]; v1 = v1 * r * gv[bj][1]; }
                    else if (kind == 2) {
#pragma unroll
                        for (int i = 0; i < 4; ++i) { v0[i] = sigmoidf_(v0[i]); v1[i] = sigmoidf_(v1[i]); } }
                    u32x4 w; if (kind == 5 || kind == 1) {   w.x = cvt_pk_f16(v0[0], v0[1]); w.y = cvt_pk_f16(v0[2], v0[3]); w.z = cvt_pk_f16(v1[0], v1[1]); w.w = cvt_pk_f16(v1[2], v1[3]); }
                    else { w.x = cvt_pk_bf16(v0[0], v0[1]); w.y = cvt_pk_bf16(v0[2], v0[3]); w.z = cvt_pk_bf16(v1[0], v1[1]); w.w = cvt_pk_bf16(v1[2], v1[3]); }
                    *(u32x4*)(rowp + 32 * bj) = w; } }
    }
};
template <int MODE> struct EpiMerge {
    static constexpr bool PERM = true;
    const bf16_t* G; bf16_t* O;
    __device__ __forceinline__ void operator()(const f32x4 (&acc)[2][2][4][2], const Unit& u, int wr, int wc, int fr_in, int fq_in) const {
        int fr = fr_in, fq = fq_in; asm volatile("" : "+v"(fr), "+v"(fq));
        const int row0 = u.pm * BM + wr * 64 + fr, col0 = u.pn * BM + wc * 32 + 8 * fq;
        const PG8_GAS bf16_t* Gg = (const PG8_GAS bf16_t*)G; PG8_GAS bf16_t* Og = (PG8_GAS bf16_t*)O;
#pragma unroll
        for (int ai = 0; ai < 2; ++ai) {
            u32x4 gwv[4][2], owv[4][2];
#pragma unroll
            for (int m = 0; m < 4; ++m)
#pragma unroll
                for (int bj = 0; bj < 2; ++bj) { const size_t off = (size_t)(row0 + ai * HALF + m * 16) * 1024 + col0 + bj * HALF; gwv[m][bj] = *(const PG8_GAS u32x4*)(Gg + off); if (MODE == 1) owv[m][bj] = *(const PG8_GAS u32x4*)(Og + off); }
#pragma unroll
            for (int m = 0; m < 4; ++m)
#pragma unroll
                for (int bj = 0; bj < 2; ++bj) { const size_t off = (size_t)(row0 + ai * HALF + m * 16) * 1024 + col0 + bj * HALF; const u32x4 gw = gwv[m][bj]; const f32x4 a0 = acc[ai][bj][m][0], a1 = acc[ai][bj][m][1];
                    float r[8]; r[0] = bflo(gw.x) * a0[0]; r[1] = bfhi(gw.x) * a0[1]; r[2] = bflo(gw.y) * a0[2]; r[3] = bfhi(gw.y) * a0[3]; r[4] = bflo(gw.z) * a1[0]; r[5] = bfhi(gw.z) * a1[1]; r[6] = bflo(gw.w) * a1[2]; r[7] = bfhi(gw.w) * a1[3];
                    if (MODE == 1) { const u32x4 ow = owv[m][bj]; r[0] += bflo(ow.x); r[1] += bfhi(ow.x); r[2] += bflo(ow.y); r[3] += bfhi(ow.y); r[4] += bflo(ow.z); r[5] += bfhi(ow.z); r[6] += bflo(ow.w); r[7] += bfhi(ow.w); }
                    u32x4 w; w.x = cvt_pk_bf16(r[0], r[1]); w.y = cvt_pk_bf16(r[2], r[3]); w.z = cvt_pk_bf16(r[4], r[5]); w.w = cvt_pk_bf16(r[6], r[7]);
                    *(PG8_GAS u32x4*)(Og + off) = w; }
        }
    }
};
struct EpiOut {
    static constexpr bool PERM = true;
    const float* X; float* O;
    __device__ __forceinline__ void operator()(const f32x4 (&acc)[2][2][4][2], const Unit& u, int wr, int wc, int fr_in, int fq_in) const {
        int fr = fr_in, fq = fq_in; asm volatile("" : "+v"(fr), "+v"(fq));
        const int row0 = u.pm * BM + wr * 64 + fr, col0 = u.pn * BM + wc * 32 + 8 * fq;
        const PG8_GAS float* Xg = (const PG8_GAS float*)X; PG8_GAS float* Og = (PG8_GAS float*)O;
#pragma unroll
        for (int ai = 0; ai < 2; ++ai) {
            f32x4 xv[4][2][2];
#pragma unroll
            for (int m = 0; m < 4; ++m)
#pragma unroll
                for (int bj = 0; bj < 2; ++bj)
#pragma unroll
                    for (int n = 0; n < 2; ++n) xv[m][bj][n] = *(const PG8_GAS f32x4*)(Xg + (size_t)(row0 + ai * HALF + m * 16) * 1024 + col0 + bj * HALF + 4 * n);
#pragma unroll
            for (int m = 0; m < 4; ++m)
#pragma unroll
                for (int bj = 0; bj < 2; ++bj)
#pragma unroll
                    for (int n = 0; n < 2; ++n) *(PG8_GAS f32x4*)(Og + (size_t)(row0 + ai * HALF + m * 16) * 1024 + col0 + bj * HALF + 4 * n) = xv[m][bj][n] + acc[ai][bj][m][n];
        }
    }
};
__device__ __forceinline__ float swiglu1(float g, float l) { g = fminf(g, 7.0f); l = fminf(fmaxf(l, -7.0f), 7.0f); return g * fast_rcp(1.f + fast_exp2(-1.702f * LOG2E * g)) * (l + 1.0f); }
struct EpiSwiglu {
    static constexpr bool PERM = true;
    bf16_t* ACT; const float* bgu;
    __device__ __forceinline__ void operator()(const f32x4 (&acc)[2][2][4][2], const Unit& u, int wr, int wc, int fr_in, int fq_in) const {
        int fr = fr_in, fq = fq_in; asm volatile("" : "+v"(fr), "+v"(fq));
        const int e = u.pb >> 3, row0 = u.pm * BM + wr * 64 + fr, colt = u.pn * BM + wc * 32 + 8 * fq;
        f32x4 bv[2][2];
#pragma unroll
        for (int bj = 0; bj < 2; ++bj)
#pragma unroll
            for (int n = 0; n < 2; ++n) bv[bj][n] = *(const PG8_GAS f32x4*)((const PG8_GAS float*)bgu + (size_t)e * 2048 + colt + bj * HALF + 4 * n);
#pragma unroll
        for (int ai = 0; ai < 2; ++ai)
#pragma unroll
            for (int m = 0; m < 4; ++m) { bf16_t* rowp = ACT + (size_t)(row0 + ai * HALF + m * 16) * 1024 + (colt >> 1);
#pragma unroll
                for (int bj = 0; bj < 2; ++bj) { const f32x4 v0 = acc[ai][bj][m][0] + bv[bj][0], v1 = acc[ai][bj][m][1] + bv[bj][1];
                    u32x2 w; w.x = cvt_pk_bf16(swiglu1(v0[0], v0[1]), swiglu1(v0[2], v0[3])); w.y = cvt_pk_bf16(swiglu1(v1[0], v1[1]), swiglu1(v1[2], v1[3]));
                    *(u32x2*)(rowp + bj * 64) = w; } }
    }
};
struct EpiDown {
    static constexpr bool PERM = true;
    bf16_t* YF; bf16_t* ACT; bf16_t* YX; const float* bd; const float* rowgate; int pmfull; bool dry;
    __device__ __forceinline__ void operator()(const f32x4 (&acc)[2][2][4][2], const Unit& u, int wr, int wc, int fr_in, int fq_in) const {
        int fr = fr_in, fq = fq_in; asm volatile("" : "+v"(fr), "+v"(fq));
        const int e = u.pb >> 2, rl = wr * 64 + fr, colt = u.pn * BM + wc * 32 + 8 * fq;
        bf16_t* ybase = (u.pm < 256) ? YF + (size_t)u.pm * BM * 1024 : (u.pm < pmfull) ? ACT + (size_t)(u.pm - 256) * BM * 1024 : YX + (size_t)(u.pm - pmfull) * BM * 1024;
        f32x4 bv[2][2];
#pragma unroll
        for (int bj = 0; bj < 2; ++bj)
#pragma unroll
            for (int n = 0; n < 2; ++n) bv[bj][n] = *(const PG8_GAS f32x4*)((const PG8_GAS float*)bd + (size_t)e * 1024 + colt + bj * HALF + 4 * n);
        float gtv[2][4];
#pragma unroll
        for (int ai = 0; ai < 2; ++ai)
#pragma unroll
            for (int m = 0; m < 4; ++m) gtv[ai][m] = ((const PG8_GAS float*)rowgate)[u.pm * BM + rl + ai * HALF + m * 16];
#pragma unroll
        for (int ai = 0; ai < 2; ++ai)
#pragma unroll
            for (int m = 0; m < 4; ++m) { const int r = rl + ai * HALF + m * 16; const float gt = gtv[ai][m]; bf16_t* rowp = ybase + (size_t)r * 1024 + colt;
#pragma unroll
                for (int bj = 0; bj < 2; ++bj) { const f32x4 y0 = (acc[ai][bj][m][0] + bv[bj][0]) * gt, y1 = (acc[ai][bj][m][1] + bv[bj][1]) * gt;
                    u32x4 w; w.x = cvt_pk_bf16(y0[0], y0[1]); w.y = cvt_pk_bf16(y0[2], y0[3]); w.z = cvt_pk_bf16(y1[0], y1[1]); w.w = cvt_pk_bf16(y1[2], y1[3]);
                    if (!dry || w.x == 0x12345678u) *(u32x4*)(rowp + bj * HALF) = w; } }
    }
};
}

__device__ __forceinline__ void p0_transpose_item(const float* W, int K, int N, bf16* WT, LAS float* scr, int item, int lane, const float* kscale) {
    const int nblk = N / 32, kb = item / nblk, nb = item % nblk, k0 = 64 * kb, n0 = 32 * nb;
    f32x4 v[8];
#pragma unroll
    for (int i = 0; i < 8; ++i) { const int kk = 8 * i + (lane >> 3); v[i] = *(const GAS f32x4*)(W + (size_t)(k0 + kk) * N + n0 + 4 * (lane & 7)); if (kscale) v[i] = v[i] * kscale[k0 + kk]; }
#pragma unroll
    for (int i = 0; i < 8; ++i) { const int kk = 8 * i + (lane >> 3); LAS float* d = scr + kk * 33 + 4 * (lane & 7); d[0] = v[i].x; d[1] = v[i].y; d[2] = v[i].z; d[3] = v[i].w; }
    LDS_WAIT(); asm volatile("" ::: "memory");
    const int c = lane & 7;
#pragma unroll
    for (int j = 0; j < 4; ++j) { const int n = (lane >> 3) + 8 * j; const LAS float* s = scr + (8 * c) * 33 + n;
        v4u o; o.x = pk2(s[0 * 33], s[1 * 33]); o.y = pk2(s[2 * 33], s[3 * 33]); o.z = pk2(s[4 * 33], s[5 * 33]); o.w = pk2(s[6 * 33], s[7 * 33]);
        *(GAS v4u*)(WT + (size_t)(n0 + n) * K + k0 + 8 * c) = o; }
    LDS_WAIT(); asm volatile("" ::: "memory");
}
__device__ __forceinline__ int win_src_col(int p) {
    const int pn = p >> 8, rem = p & 255, bj = rem >> 7, wc = (rem >> 5) & 3, j = rem & 31, hs = pn * 4 + wc, dim = 32 * bj + j;
    if (hs < 8) return hs * 64 + dim;
    if (hs < 16) return 1304 + (hs - 8) * 64 + dim;
    if (hs < 18) return 768 + (hs - 16) * 64 + dim;
    if (hs < 20) return 1024 + (hs - 18) * 64 + dim;
    if (hs < 22) return 512 + (hs - 20) * 64 + dim;
    if (hs < 24) return 640 + (hs - 22) * 64 + dim;
    if (hs < 26) return 896 + (hs - 24) * 64 + dim;
    if (hs < 28) return 1152 + (hs - 26) * 64 + dim;
    if (hs < 36) return 1944 + (hs - 28) * 64 + dim;
    if (hs < 38) return 1816 + (hs - 36) * 64 + dim;
    if (hs == 38) return 2456 + dim;
    if (hs == 39) return dim < 8 ? 2520 + dim : (dim < 32 ? 1280 + (dim - 8) : -1);
    if (hs < 56) return 2528 + (hs - 40) * 64 + dim;
    return 3552 + (hs - 56) * 64 + dim;
}
__device__ __forceinline__ void p0_win_item(const float* W, bf16* WT, LAS float* scr, int item, int lane) {
    const int nblk = NPIN / 32, kb = item / nblk, nb = item % nblk, k0 = 64 * kb, n0 = 32 * nb;
    const int col = win_src_col(n0 + (lane & 31));
#pragma unroll 8
    for (int i = 0; i < 32; ++i) { const int kk = 2 * i + (lane >> 5); scr[kk * 33 + (lane & 31)] = col >= 0 ? W[(size_t)(k0 + kk) * DIN + col] : 0.f; }
    LDS_WAIT(); asm volatile("" ::: "memory");
    const int c = lane & 7;
#pragma unroll
    for (int j = 0; j < 4; ++j) { const int n = (lane >> 3) + 8 * j; const LAS float* s = scr + (8 * c) * 33 + n;
        v4u o; o.x = pk2(s[0 * 33], s[1 * 33]); o.y = pk2(s[2 * 33], s[3 * 33]); o.z = pk2(s[4 * 33], s[5 * 33]); o.w = pk2(s[6 * 33], s[7 * 33]);
        *(GAS v4u*)(WT + (size_t)(n0 + n) * 1024 + k0 + 8 * c) = o; }
    LDS_WAIT(); asm volatile("" ::: "memory");
}
__device__ __forceinline__ void rms_row_to_bf16(const float* xrow, const float* gain, bf16* orow, int lane) {
    const GAS f32x4* xr = (const GAS f32x4*)xrow + lane; const GAS f32x4* gr = (const GAS f32x4*)gain + lane;
    f32x4 v[4]; float s = 0.f;
#pragma unroll
    for (int j = 0; j < 4; ++j) { v[j] = xr[64 * j]; s += (v[j].x * v[j].x + v[j].y * v[j].y) + (v[j].z * v[j].z + v[j].w * v[j].w); }
    const float r = 1.f / sqrtf(wave_sum(s) * (1.f / DM) + NORM_EPS);
    GAS unsigned long long* o8 = (GAS unsigned long long*)orow + lane;
#pragma unroll
    for (int j = 0; j < 4; ++j) { const f32x4 g = gr[64 * j]; o8[64 * j] = (unsigned long long)pk2(v[j].x * r * g.x, v[j].y * r * g.y) | ((unsigned long long)pk2(v[j].z * r * g.z, v[j].w * r * g.w) << 32); }
}

struct Args { const float* in[29]; float* out; unsigned char* ws; int ph_lo, ph_hi, dup, mode; };

__device__ __forceinline__ void p0_prologue(Frame& F, const Args& A) {
    LAS float* scr = (LAS float*)(F.lds + RING_OFF + F.wave * 16384);
    int lane_ = F.lane; asm volatile("" : "+v"(lane_));
    const int gw = F.vcu * NWAVES + F.wave, NGW = F.G * NWAVES, lane = lane_;
    unsigned char* ws = F.ws;
    constexpr int I_WIN = (DM / 64) * (NPIN / 32);
    constexpr int I_WA = (512 / 64) * (1024 / 32);
    constexpr int I_WO = (1024 / 64) * (1024 / 32);
    constexpr int I_W1 = (1024 / 64) * (2048 / 32);
    constexpr int I_W2 = (1024 / 64) * (1024 / 32);
    constexpr int I_CW1 = (2048 / 64) * (128 / 32);
    constexpr int I_CW2 = (128 / 64) * (64 / 32);
    constexpr int NITEMS = I_WIN + 2 * I_WA + I_WO + 2 * I_CW1 + 4 * I_CW2;
    for (int it = gw; it < NITEMS; it += NGW) {
        int r = it;
        if (r < I_WIN) { p0_win_item(INP(2), (bf16*)(ws + WS_WIN), scr, r, lane); continue; } r -= I_WIN;
        if (r < I_WA) { p0_transpose_item(INP(18), 512, 1024, (bf16*)(ws + WS_WA), scr, r, lane, nullptr); continue; } r -= I_WA;
        if (r < I_WA) { p0_transpose_item(INP(19), 512, 1024, (bf16*)(ws + WS_WB), scr, r, lane, nullptr); continue; } r -= I_WA;
        if (r < I_WO) { p0_transpose_item(INP(20), 1024, 1024, (bf16*)(ws + WS_WO), scr, r, lane, nullptr); continue; } r -= I_WO;
        if (r < I_CW1) { p0_transpose_item(INP(6), 2048, 128, (bf16*)(ws + WS_CW1K), scr, r, lane, nullptr); continue; } r -= I_CW1;
        if (r < I_CW1) { p0_transpose_item(INP(10), 2048, 128, (bf16*)(ws + WS_CW1V), scr, r, lane, nullptr); continue; } r -= I_CW1;
        if (r < I_CW2) { p0_transpose_item(INP(8), 128, 64, (bf16*)(ws + WS_CW2K), scr, r, lane, nullptr); continue; } r -= I_CW2;
        if (r < I_CW2) { p0_transpose_item(INP(12), 128, 64, (bf16*)(ws + WS_CW2V), scr, r, lane, nullptr); continue; } r -= I_CW2;
        if (r < I_CW2) { p0_transpose_item(INP(14), 128, 64, (bf16*)(ws + WS_WUK), scr, r, lane, INP(13)); continue; } r -= I_CW2;
        p0_transpose_item(INP(15), 128, 64, (bf16*)(ws + WS_WUV), scr, r, lane, INP(13));
    }
    { const float* X = INP(0); const GAS f32x4* gr = (const GAS f32x4*)INP(1) + lane; bf16* XN = (bf16*)(ws + WS_XN);
      for (int m = gw; m < NTOK; m += 2 * NGW) {
        f32x4 v[2][4]; float sq[2];
#pragma unroll
        for (int u = 0; u < 2; ++u) { const GAS f32x4* xr = (const GAS f32x4*)(X + (size_t)(m + u * NGW) * DM) + lane;
#pragma unroll
            for (int j = 0; j < 4; ++j) v[u][j] = xr[64 * j]; }
#pragma unroll
        for (int u = 0; u < 2; ++u) { float s_ = 0.f;
#pragma unroll
            for (int j = 0; j < 4; ++j) s_ += (v[u][j].x * v[u][j].x + v[u][j].y * v[u][j].y) + (v[u][j].z * v[u][j].z + v[u][j].w * v[u][j].w);
            sq[u] = s_; }
#pragma unroll
        for (int o = 1; o < 64; o <<= 1) { sq[0] += __shfl_xor(sq[0], o); sq[1] += __shfl_xor(sq[1], o); }
#pragma unroll
        for (int u = 0; u < 2; ++u) { const float r = 1.f / sqrtf(sq[u] * (1.f / DM) + NORM_EPS); GAS unsigned long long* o8 = (GAS unsigned long long*)(XN + (size_t)(m + u * NGW) * DM) + lane;
#pragma unroll
            for (int j = 0; j < 4; ++j) { const f32x4 g = gr[64 * j]; o8[64 * j] = (unsigned long long)pk2(v[u][j].x * r * g.x, v[u][j].y * r * g.y) | ((unsigned long long)pk2(v[u][j].z * r * g.z, v[u][j].w * r * g.w) << 32); } }
      } }
    const int gt = F.vcu * (NWAVES * 64) + F.tid, NGT = F.G * NWAVES * 64;
    { float* wrp = (float*)(ws + WS_WRP); const float* wr = INP(23); const float* fg = INP(22);
      for (int i = gt; i < 1024 * 32; i += NGT) wrp[i] = wr[i] * fg[i >> 5]; }
    { float* lut = (float*)(ws + WS_BIASLUT); const float* rb = INP(21);
      for (int i = gt; i < 16 * 128 + 16; i += NGT) { if (i < 2048) { const int h = i >> 7, n = i & 127; lut[i] = rb[(int)REL_BUCKET[n] * 16 + h] * LOG2E; } else lut[i] = rb[31 * 16 + (i - 2048)] * LOG2E; }
      if (gt == 0) { for (int br = 0; br < 2; ++br) { const float* gq = br ? INP(16) : INP(3); const float* gk = br ? INP(17) : INP(4); float mq = 0.f, mk = 0.f; for (int i = 0; i < 64; ++i) { mq = fmaxf(mq, fabsf(gq[i])); mk = fmaxf(mk, fabsf(gk[i])); } lut[2064 + br] = 64.0f * QSCALE * mq * mk; } } }
    if (gw >= NGW - 8) { const int it = gw - (NGW - 8), mat = it >> 2, cg = it & 3; const float* pe = INP(mat ? 9 : 5); const float* w1 = INP(mat ? 10 : 6); const float* b1 = INP(mat ? 11 : 7);
        const int c = cg * 32 + (lane & 31), kh = lane >> 5; float s = 0.f;
#pragma unroll 8
        for (int k = 0; k < 1024; ++k) { const int kk = kh * 1024 + k; s += pe[kk] * w1[(size_t)kk * 128 + c]; }
        s += __shfl_xor(s, 32);
        if (lane < 32) ((float*)(ws + (mat ? WS_CB1V : WS_CB1K)))[c] = s + b1[c]; }
}

__device__ __forceinline__ void moe_weight_items(Frame& F, int gw2, int ngw2, int lane) {
    LAS float* scr = (LAS float*)(F.lds + RING_OFF + F.wave * 16384); unsigned char* ws = F.ws;
    constexpr int I_W1 = (1024 / 64) * (2048 / 32), I_W2 = (1024 / 64) * (1024 / 32);
    for (int it = gw2; it < NEXP * (I_W1 + I_W2); it += ngw2) {
        if (it < NEXP * I_W1) { const int e = it / I_W1; p0_transpose_item(INP(25) + (size_t)e * 1024 * 2048, 1024, 2048, (bf16*)(ws + WS_W1T) + (size_t)e * 2048 * 1024, scr, it % I_W1, lane, nullptr); }
        else { const int r = it - NEXP * I_W1, e = r / I_W2; p0_transpose_item(INP(27) + (size_t)e * 1024 * 1024, 1024, 1024, (bf16*)(ws + WS_W2T) + (size_t)e * 1024 * 1024, scr, r % I_W2, lane, nullptr); }
    }
}
__device__ __forceinline__ float row_ror_f(float x, const int n) { return __builtin_bit_cast(float, n == 8 ? __builtin_amdgcn_mov_dpp(__builtin_bit_cast(int, x), 0x128, 0xf, 0xf, true) : n == 4 ? __builtin_amdgcn_mov_dpp(__builtin_bit_cast(int, x), 0x124, 0xf, 0xf, true) : n == 2 ? __builtin_amdgcn_mov_dpp(__builtin_bit_cast(int, x), 0x122, 0xf, 0xf, true) : __builtin_amdgcn_mov_dpp(__builtin_bit_cast(int, x), 0x121, 0xf, 0xf, true)); }
__device__ __forceinline__ int row_ror_i(int x, const int n) { return n == 8 ? __builtin_amdgcn_mov_dpp(x, 0x128, 0xf, 0xf, true) : n == 4 ? __builtin_amdgcn_mov_dpp(x, 0x124, 0xf, 0xf, true) : n == 2 ? __builtin_amdgcn_mov_dpp(x, 0x122, 0xf, 0xf, true) : __builtin_amdgcn_mov_dpp(x, 0x121, 0xf, 0xf, true); }
__device__ __forceinline__ float row_max16(float v) { v = fmaxf(v, row_ror_f(v, 8)); v = fmaxf(v, row_ror_f(v, 4)); v = fmaxf(v, row_ror_f(v, 2)); v = fmaxf(v, row_ror_f(v, 1)); return v; }
__device__ __forceinline__ int row_min16(int v) { int t; t = row_ror_i(v, 8); v = t < v ? t : v; t = row_ror_i(v, 4); v = t < v ? t : v; t = row_ror_i(v, 2); v = t < v ? t : v; t = row_ror_i(v, 1); v = t < v ? t : v; return v; }
__device__ __forceinline__ void router_phase(Frame& F, const Args& A, const bool dry = false) {
    unsigned char* ws = F.ws; int tid_ = F.tid; asm volatile("" : "+v"(tid_)); const int tid = tid_, lane = tid & 63, w = F.wave;
    LAS float* part = (LAS float*)(F.lds);
    LAS float* ssq = (LAS float*)(F.lds + 34816);
    LAS float* rinv = (LAS float*)(F.lds + 41216);
    LAS int* pe = (LAS int*)(F.lds + 41472);
    LAS float* pg = (LAS float*)(F.lds + 41984);
    LAS int* plp = (LAS int*)(F.lds + 42496);
    LAS int* hist = (LAS int*)(F.lds + 43008);
    LAS int* hbase = (LAS int*)(F.lds + 43136);
    const float* wrp = (const float*)(ws + WS_WRP); const float* fg = INP(22); const float* br = INP(24);
    bf16* XN2 = (bf16*)(ws + WS_XN);
    const int i = lane & 31, h = lane >> 5, kb = 128 * w + 64 * h;
    float wreg[64];
#pragma unroll
    for (int s = 0; s < 64; ++s) wreg[s] = wrp[(size_t)(kb + s) * 32 + i];
    const int tk = tid >> 4, e0 = (tid & 15) * 2; const float br0 = br[e0], br1 = br[e0 + 1];
    f32x4 xa[16];
    { const float* xr0 = F.out + (size_t)(F.vcu * 32 + i) * DM + kb;
#pragma unroll
      for (int j = 0; j < 16; ++j) xa[j] = *(const GAS f32x4*)(xr0 + 4 * j); }
    for (int unit = F.vcu; unit < NTOK / 32; unit += F.G) {
        const int t0 = unit * 32;
        if (tid < 32) hist[tid] = 0;
        f32x4 xn[16]; const bool has_next = unit + F.G < NTOK / 32;
        if (has_next) { const float* xr1 = F.out + (size_t)((unit + F.G) * 32 + i) * DM + kb;
#pragma unroll
            for (int j = 0; j < 16; ++j) xn[j] = *(const GAS f32x4*)(xr1 + 4 * j); }
        __builtin_amdgcn_sched_barrier(0);
        f32x16 acc;
#pragma unroll
        for (int r = 0; r < 16; ++r) acc[r] = 0.f;
        float ss = 0.f;
#pragma unroll
        for (int s = 0; s < 64; ++s) { const float a = xa[s >> 2][s & 3]; acc = __builtin_amdgcn_mfma_f32_32x32x2f32(a, wreg[s], acc, 0, 0, 0); ss += a * a; }
#pragma unroll
        for (int r = 0; r < 16; ++r) part[(w * 32 + ((r & 3) + 8 * (r >> 2) + 4 * h)) * 33 + i] = acc[r];
        ssq[w * 64 + lane] = ss;
        __syncthreads();
        { float s2 = 0.f;
#pragma unroll
          for (int ww = 0; ww < 8; ++ww) s2 += ssq[ww * 64 + tk] + ssq[ww * 64 + tk + 32];
          const float r = 1.f / sqrtf(s2 * (1.f / DM) + NORM_EPS);
          if ((tid & 15) == 0) rinv[tk] = r;
          float v0 = 0.f, v1 = 0.f;
#pragma unroll
          for (int ww = 0; ww < 8; ++ww) { v0 += part[(ww * 32 + tk) * 33 + e0]; v1 += part[(ww * 32 + tk) * 33 + e0 + 1]; }
          float la = v0 * r + br0, lb = v1 * r + br1;
          float tv[4]; int te[4];
#pragma unroll
          for (int k = 0; k < 4; ++k) { const float M = row_max16(fmaxf(la, lb)); const int ci = (la == M) ? e0 : ((lb == M) ? e0 + 1 : 64); const int I = row_min16(ci);
              tv[k] = M; te[k] = I; la = (e0 == I) ? -3.0e38f : la; lb = (e0 + 1 == I) ? -3.0e38f : lb; }
          float p[4], sum = 0.f;
#pragma unroll
          for (int k = 0; k < 4; ++k) { p[k] = __expf(tv[k] - tv[0]); sum += p[k]; }
          const float inv = 1.f / sum; const int kk = tid & 15;
          if (kk < 4) { const int e = kk == 0 ? te[0] : kk == 1 ? te[1] : kk == 2 ? te[2] : te[3]; const float g = (kk == 0 ? p[0] : kk == 1 ? p[1] : kk == 2 ? p[2] : p[3]) * inv;
              pe[tk * 4 + kk] = e; pg[tk * 4 + kk] = g; plp[tk * 4 + kk] = atomicAdd((int*)&hist[e], 1); } }
        __syncthreads();
        { const float r = rinv[i]; bf16* orow = XN2 + (size_t)(t0 + i) * DM + kb;
#pragma unroll
          for (int j = 0; j < 16; ++j) { const f32x4 g = *(const GAS f32x4*)(fg + kb + 4 * j); const f32x4 v = xa[j] * r * g; v2u o; o.x = pk2(v.x, v.y); o.y = pk2(v.z, v.w); *(GAS v2u*)(orow + 4 * j) = o; } }
        if (tid < 32) { const int n = hist[tid]; hbase[tid] = (n && !dry) ? (int)__hip_atomic_fetch_add((unsigned*)(F.ctl + CW_CNT + 64 * tid), (unsigned)n, RLX_AGENT) : 0; }
        __syncthreads();
        if (tid < 128 && !dry) {
            int* TE = (int*)(ws + WS_TOKE); float* TG = (float*)(ws + WS_TOKG); int* TP = (int*)(ws + WS_TOKP);
            const int e = pe[tid]; TE[t0 * 4 + tid] = e; TG[t0 * 4 + tid] = pg[tid]; TP[t0 * 4 + tid] = hbase[e] + plp[tid];
        }
        __syncthreads();
        if (has_next) {
#pragma unroll
            for (int j = 0; j < 16; ++j) xa[j] = xn[j]; }
    }
}

__device__ __forceinline__ void dispatch_phase(Frame& F) {
    unsigned char* ws = F.ws; const int tid = F.tid;
    LAS int* pstart = (LAS int*)(F.lds);
    LAS int* cnts = (LAS int*)(F.lds + 256);
    if (tid < 32) cnts[tid] = (int)__hip_atomic_load((unsigned*)(F.ctl + CW_CNT + 64 * tid), RLX_AGENT);
    __syncthreads();
    if (tid == 0) { int a = 0; for (int e = 0; e < 32; ++e) { pstart[e] = a; a += (cnts[e] + 255) & ~255; } pstart[32] = a; }
    __syncthreads();
    int* TILEE = (int*)(ws + WS_TILEE); int* ROWTOK = (int*)(ws + WS_ROWTOK); float* ROWGATE = (float*)(ws + WS_ROWGATE);
    if (blockIdx.x == 0) {
        const int T = pstart[32] >> 8;
        for (int pm = tid; pm < T; pm += NWAVES * 64) { int e = 0; for (int q = 1; q < 32; ++q) if (pstart[q] <= pm * 256) e = q; TILEE[pm] = e; }
        if (tid == 0) TILEE[2048] = T;
    }
    if (blockIdx.x < 32) { const int e = blockIdx.x; for (int r = pstart[e] + cnts[e] + tid; r < pstart[e + 1]; r += NWAVES * 64) { ROWTOK[r] = -1; ROWGATE[r] = 0.f; } }
    const int* TE = (const int*)(ws + WS_TOKE); const float* TG = (const float*)(ws + WS_TOKG); const int* TP = (const int*)(ws + WS_TOKP);
    for (int idx = blockIdx.x * (NWAVES * 64) + tid; idx < NTOK * TOPK; idx += F.G * NWAVES * 64) { const int e = TE[idx]; const int row = pstart[e] + TP[idx]; ROWTOK[row] = idx >> 2; ROWGATE[row] = TG[idx]; ((int*)(ws + WS_TOKP))[idx] = row; }
    __syncthreads();
}

__device__ __forceinline__ void combine_phase(Frame& F, const bool dry) {
    unsigned char* ws = F.ws; const int lane = F.lane; const int gw = F.vcu * NWAVES + F.wave, NGW = F.G * NWAVES;
    const int* TROW = (const int*)(ws + WS_TOKP); const bf16* YF = (const bf16*)(ws + WS_XN); const bf16* YA = (const bf16*)(ws + WS_ACT); const bf16* YX = (const bf16*)(ws + WS_YX);
    const int rowfull = (__builtin_amdgcn_readfirstlane(((const int*)(ws + WS_TILEE))[2048]) / 256) * 65536;
    for (int tok0 = gw; tok0 < NTOK; tok0 += 2 * NGW) {
        float* op[2]; f32x4 a[2][4]; v4u y[2][4][2];
#pragma unroll
        for (int u = 0; u < 2; ++u) { const int tok = tok0 + u * NGW; op[u] = F.out + (size_t)tok * DM + lane * 16;
#pragma unroll
            for (int k = 0; k < 4; ++k) { const int row = __builtin_amdgcn_readfirstlane(TROW[tok * 4 + k]);
                const bf16* yp = (row < 65536 ? YF + (size_t)row * 1024 : row < rowfull ? YA + (size_t)(row - 65536) * 1024 : YX + (size_t)(row - rowfull) * 1024) + lane * 16;
                y[u][k][0] = *(const GAS v4u*)yp; y[u][k][1] = *(const GAS v4u*)(yp + 8); }
#pragma unroll
            for (int j = 0; j < 4; ++j) a[u][j] = *(const GAS f32x4*)(op[u] + 4 * j); }
#pragma unroll
        for (int u = 0; u < 2; ++u) {
#pragma unroll
            for (int k = 0; k < 4; ++k) { const v4u y0 = y[u][k][0], y1 = y[u][k][1];
                a[u][0] += (f32x4){bflo(y0.x), bfhi(y0.x), bflo(y0.y), bfhi(y0.y)}; a[u][1] += (f32x4){bflo(y0.z), bfhi(y0.z), bflo(y0.w), bfhi(y0.w)};
                a[u][2] += (f32x4){bflo(y1.x), bfhi(y1.x), bflo(y1.y), bfhi(y1.y)}; a[u][3] += (f32x4){bflo(y1.z), bfhi(y1.z), bflo(y1.w), bfhi(y1.w)}; }
            if (!dry) {
#pragma unroll
                for (int j = 0; j < 4; ++j) *(GAS f32x4*)(op[u] + 4 * j) = a[u][j];
            } else if (a[u][0].x == 1.2345e30f) *(GAS f32x4*)(op[u]) = a[u][1] + a[u][2] + a[u][3]; }
    }
}

__device__ __forceinline__ f32x16 mfma32(bf16x8 a, bf16x8 b, f32x16 c) { return __builtin_amdgcn_mfma_f32_32x32x16_bf16(a, b, c, 0, 0, 0); }
typedef _Float16 f16x8 __attribute__((ext_vector_type(8)));
__device__ __forceinline__ f32x16 mfma32h(bf16x8 a, bf16x8 b, f32x16 c) { return __builtin_amdgcn_mfma_f32_32x32x16_f16(__builtin_bit_cast(f16x8, a), __builtin_bit_cast(f16x8, b), c, 0, 0, 0); }
__device__ __forceinline__ float half_sum(float x) { auto t = __builtin_amdgcn_permlane32_swap(__float_as_uint(x), __float_as_uint(x), false, false); return __uint_as_float(t[0]) + __uint_as_float(t[1]); }
__device__ __forceinline__ float half_max(float x) { auto t = __builtin_amdgcn_permlane32_swap(__float_as_uint(x), __float_as_uint(x), false, false); return fmaxf(__uint_as_float(t[0]), __uint_as_float(t[1])); }
__device__ __forceinline__ f32x16 zero16() { f32x16 z;
#pragma unroll
    for (int i = 0; i < 16; ++i) z[i] = 0.f; return z; }
__device__ __forceinline__ bf16x8 pack8(const f32x16& p, int base) {
    v4u w; w.x = pg8::cvt_pk_bf16(p[base + 0], p[base + 1]); w.y = pg8::cvt_pk_bf16(p[base + 2], p[base + 3]); w.z = pg8::cvt_pk_bf16(p[base + 4], p[base + 5]); w.w = pg8::cvt_pk_bf16(p[base + 6], p[base + 7]);
    return __builtin_bit_cast(bf16x8, w); }
__device__ __forceinline__ unsigned ord_key(float f) { const unsigned u = __float_as_uint(f); return (u & 0x80000000u) ? ~u : (u | 0x80000000u); }
__device__ __forceinline__ float gelu_tanh(float x) { const float u = 0.7978845608028654f * (x + 0.044715f * x * x * x); return x * fast_rcp(1.f + fast_exp2(-2.f * LOG2E * u)); }
constexpr float NEG_INF = -__builtin_inff();
__device__ __forceinline__ float dpp_xor1(float x) { return __builtin_bit_cast(float, __builtin_amdgcn_mov_dpp(__builtin_bit_cast(int, x), 0xB1, 0xf, 0xf, true)); }
__device__ __forceinline__ float dpp_xor2(float x) { return __builtin_bit_cast(float, __builtin_amdgcn_mov_dpp(__builtin_bit_cast(int, x), 0x4E, 0xf, 0xf, true)); }
typedef float f32x2 __attribute__((ext_vector_type(2)));
__device__ __forceinline__ float relu_i(float x) { const int b = __builtin_bit_cast(int, x); return __builtin_bit_cast(float, b > 0 ? b : 0); }
__device__ __forceinline__ float vmax(float a, float b) { float r; asm("v_max_f32_e32 %0, %1, %2" : "=v"(r) : "v"(a), "v"(b)); return r; }

__device__ __forceinline__ void small_phase(Frame& F, const Args& A) {
    unsigned char* ws = F.ws; int lane_ = F.lane; asm volatile("" : "+v"(lane_)); const int lane = lane_, q = lane & 31, hh = lane >> 5;
    const int gw = F.vcu * NWAVES + F.wave, NGW = F.G * NWAVES;
    {
        const int kq = F.wave & 3, un = F.vcu + 256 * (F.wave >> 2);
        const int mat = un >> 8, bg = (un >> 4) & 15, ib = un & 15, b = bg >> 1, g = bg & 1;
        const bf16* SRC = (const bf16*)(ws + (mat ? WS_CV : WS_CK)); const bf16* W1T = (const bf16*)(ws + (mat ? WS_CW1V : WS_CW1K)); const bf16* W2T = (const bf16*)(ws + (mat ? WS_CW2V : WS_CW2K));
        const float* B1 = (const float*)(ws + (mat ? WS_CB1V : WS_CB1K)); const float* b2dummy = nullptr; (void)b2dummy;
        const int ci = ib * 32 + q;
        const int tokb = 16 * ci;
        f32x16 acc[4];
#pragma unroll
        for (int mt = 0; mt < 4; ++mt) acc[mt] = zero16();
#pragma unroll 4
        for (int s = 32 * kq; s < 32 * kq + 32; ++s) {
            const int k = 16 * s + 8 * hh; int tok = tokb + (k >> 6); tok = tok > SEQ - 1 ? SEQ - 1 : tok;
            const bf16x8 bf = *(const GAS bf16x8*)(SRC + ((size_t)(b * SEQ + tok)) * 128 + g * 64 + (k & 63));
#pragma unroll
            for (int mt = 0; mt < 4; ++mt) { const bf16x8 af = *(const GAS bf16x8*)(W1T + (size_t)(32 * mt + q) * 2048 + k); acc[mt] = mfma32(af, bf, acc[mt]); }
        }
        { LAS float* red = (LAS float*)(F.lds);
          if (kq != 0) {
#pragma unroll
              for (int mt = 0; mt < 4; ++mt)
#pragma unroll
                  for (int r = 0; r < 16; ++r) red[((F.wave * 64 + mt * 16 + r) * 64) + lane] = acc[mt][r]; }
          __syncthreads();
          if (kq == 0) {
#pragma unroll
              for (int j = 1; j < 4; ++j)
#pragma unroll
                  for (int mt = 0; mt < 4; ++mt)
#pragma unroll
                      for (int r = 0; r < 16; ++r) acc[mt][r] += red[(((F.wave + j) * 64 + mt * 16 + r) * 64) + lane]; } }
        if (kq == 0) {
#pragma unroll
        for (int mt = 0; mt < 4; ++mt)
#pragma unroll
            for (int r = 0; r < 16; ++r) { const int hid = 32 * mt + (r & 3) + 8 * (r >> 2) + 4 * hh; acc[mt][r] = gelu_tanh(acc[mt][r] + B1[hid]); }
        f32x16 o[2]; o[0] = zero16(); o[1] = zero16();
#pragma unroll
        for (int s2 = 0; s2 < 8; ++s2) { const bf16x8 bf = pack8(acc[s2 >> 1], 8 * (s2 & 1));
#pragma unroll
            for (int dt = 0; dt < 2; ++dt) { const bf16* wp = W2T + (size_t)(32 * dt + q) * 128 + 32 * (s2 >> 1) + 16 * (s2 & 1) + 4 * hh;
                const v2u a0 = *(const GAS v2u*)wp, a1 = *(const GAS v2u*)(wp + 8); v4u aw; aw.x = a0.x; aw.y = a0.y; aw.z = a1.x; aw.w = a1.y;
                o[dt] = mfma32(__builtin_bit_cast(bf16x8, aw), bf, o[dt]); } }
        if (mat == 0) {
            float ss = 0.f;
#pragma unroll
            for (int dt = 0; dt < 2; ++dt)
#pragma unroll
                for (int r = 0; r < 16; ++r) ss += o[dt][r] * o[dt][r];
            ss = half_sum(ss); const float rn = 1.f / sqrtf(ss * (1.f / 64.f) + NORM_EPS); const float* gk = INP(4);
#pragma unroll
            for (int dt = 0; dt < 2; ++dt)
#pragma unroll
                for (int r = 0; r < 16; ++r) o[dt][r] *= rn * gk[32 * dt + (r & 3) + 8 * (r >> 2) + 4 * hh];
        }
        bf16* DST = (bf16*)(ws + (mat ? WS_VC : WS_KC)) + ((size_t)bg * 512 + ci) * 64;
        const bool valid = ci < NCMP;
#pragma unroll
        for (int dt = 0; dt < 2; ++dt)
#pragma unroll
            for (int gq = 0; gq < 4; ++gq) { v2u w; w.x = !valid ? 0u : (mat == 0 ? pg8::cvt_pk_f16(o[dt][4 * gq], o[dt][4 * gq + 1]) : pg8::cvt_pk_bf16(o[dt][4 * gq], o[dt][4 * gq + 1])); w.y = !valid ? 0u : (mat == 0 ? pg8::cvt_pk_f16(o[dt][4 * gq + 2], o[dt][4 * gq + 3]) : pg8::cvt_pk_bf16(o[dt][4 * gq + 2], o[dt][4 * gq + 3]));
                *(GAS v2u*)(DST + 32 * dt + 8 * gq + 4 * hh) = w; }
        }
    }
    { const bf16* CKV = (const bf16*)(ws + WS_CKV); const bf16* WUK = (const bf16*)(ws + WS_WUK); const bf16* WUV = (const bf16*)(ws + WS_WUV); const float* gk = INP(17);
      for (int un = gw; un < NTOK / 32; un += NGW) {
        const size_t tok = (size_t)un * 32 + q;
        f32x16 ok[2], ov[2]; ok[0] = zero16(); ok[1] = zero16(); ov[0] = zero16(); ov[1] = zero16(); float ss = 0.f;
#pragma unroll
        for (int s = 0; s < 8; ++s) { const int k = 16 * s + 8 * hh; const v4u bw = *(const GAS v4u*)(CKV + tok * 128 + k);
            ss += bflo(bw.x) * bflo(bw.x) + bfhi(bw.x) * bfhi(bw.x) + bflo(bw.y) * bflo(bw.y) + bfhi(bw.y) * bfhi(bw.y) + bflo(bw.z) * bflo(bw.z) + bfhi(bw.z) * bfhi(bw.z) + bflo(bw.w) * bflo(bw.w) + bfhi(bw.w) * bfhi(bw.w);
            const bf16x8 bf = __builtin_bit_cast(bf16x8, bw);
#pragma unroll
            for (int dt = 0; dt < 2; ++dt) { ok[dt] = mfma32(*(const GAS bf16x8*)(WUK + (size_t)(32 * dt + q) * 128 + k), bf, ok[dt]); ov[dt] = mfma32(*(const GAS bf16x8*)(WUV + (size_t)(32 * dt + q) * 128 + k), bf, ov[dt]); } }
        ss = half_sum(ss); const float rc = 1.f / sqrtf(ss * (1.f / 128.f) + NORM_EPS);
        float s2 = 0.f;
#pragma unroll
        for (int dt = 0; dt < 2; ++dt)
#pragma unroll
            for (int r = 0; r < 16; ++r) { ok[dt][r] *= rc; ov[dt][r] *= rc; s2 += ok[dt][r] * ok[dt][r]; }
        s2 = half_sum(s2); const float rk = 1.f / sqrtf(s2 * (1.f / 64.f) + NORM_EPS);
        bf16* KBp = (bf16*)(ws + WS_KB) + tok * 64; bf16* VBp = (bf16*)(ws + WS_VB) + tok * 64;
#pragma unroll
        for (int dt = 0; dt < 2; ++dt)
#pragma unroll
            for (int gq = 0; gq < 4; ++gq) { const int d = 32 * dt + 8 * gq + 4 * hh; const f32x4 g4 = *(const GAS f32x4*)(gk + d);
                v2u w; w.x = pg8::cvt_pk_f16(ok[dt][4 * gq] * rk * g4.x, ok[dt][4 * gq + 1] * rk * g4.y); w.y = pg8::cvt_pk_f16(ok[dt][4 * gq + 2] * rk * g4.z, ok[dt][4 * gq + 3] * rk * g4.w);
                *(GAS v2u*)(KBp + d) = w;
                v2u v; v.x = pg8::cvt_pk_bf16(ov[dt][4 * gq], ov[dt][4 * gq + 1]); v.y = pg8::cvt_pk_bf16(ov[dt][4 * gq + 2], ov[dt][4 * gq + 3]);
                *(GAS v2u*)(VBp + d) = v; }
      } }
}

constexpr int NSA_KT = 0, NSA_VT = 18432, NSA_IMP = 36864, NSA_LUT = 69632, NSA_T2 = 77952  , NSA_TB = 9216;
struct NsaRegs { v4u k, v; };
__device__ __forceinline__ void nsa_issue(NsaRegs& R, const bf16* K, const bf16* V, size_t row0, int pitch, int coff, bool loadV, int tid) {
    const int key = tid >> 3, ch = tid & 7; const size_t off = (row0 + key) * pitch + coff + ch * 8;
    R.k = *(const GAS v4u*)(K + off); if (loadV) R.v = *(const GAS v4u*)(V + off);
}
__device__ __forceinline__ void nsa_commit(LAS unsigned char* lds, int buf, const NsaRegs& R, bool loadV, int tid) {
    const int key = tid >> 3, ch = tid & 7;
    *(LAS v4u*)(lds + NSA_KT + buf * NSA_TB + key * 144 + ch * 16) = R.k;
    if (loadV) *(LAS v4u*)(lds + NSA_VT + buf * NSA_TB + key * 144 + ch * 16) = R.v;
}
__device__ __forceinline__ void nsa_qk(f32x16& s0, f32x16& s1, const LAS unsigned char* kt, const bf16x8 (&qf)[4], int q, int hh) {
    s0 = zero16(); s1 = zero16();
#pragma unroll
    for (int s = 0; s < 4; ++s) { const bf16x8 a0 = *(const LAS bf16x8*)(kt + q * 144 + s * 32 + hh * 16); const bf16x8 a1 = *(const LAS bf16x8*)(kt + (32 + q) * 144 + s * 32 + hh * 16);
        s0 = mfma32h(a0, qf[s], s0); s1 = mfma32h(a1, qf[s], s1); }
}
template <int BR> __device__ __forceinline__ void nsa_mask_slow(f32x16& s, int kt, int hh, int tq, int base, bool lanesel, const LAS float* lutH, float farb) {
#pragma unroll
    for (int r = 0; r < 16; ++r) { const int key = 32 * kt + (r & 3) + 8 * (r >> 2) + 4 * hh; int rel; bool valid;
        if (BR == 0) { const int c = base + key; rel = tq - 16 * c - 31; valid = rel >= 0 && c < NCMP; }
        else if (BR == 1) { rel = tq - (base + key); valid = lanesel && rel >= 0; }
        else { rel = tq - (base + key); valid = rel >= 0 && rel < 512; }
        const int ri = rel < 0 ? 0 : (rel > 127 ? 127 : rel); const float bl = lutH[ri]; const float bias = rel < 128 ? bl : farb;
        s[r] = valid ? s[r] + bias : NEG_INF; }
}
__device__ __forceinline__ void nsa_mask_tab(f32x16& s, int kt, const LAS float* t2rel  ) {
#pragma unroll
    for (int r = 0; r < 16; ++r) s[r] += t2rel[-(32 * kt + (r & 3) + 8 * (r >> 2))];
}
__device__ __forceinline__ void nsa_mask_cmp(f32x16& s, int kt, int relc  , const LAS float* t2h  ) {
#pragma unroll
    for (int r = 0; r < 16; ++r) { int rel = relc - 16 * (32 * kt + (r & 3) + 8 * (r >> 2)); rel = rel < -1 ? -1 : (rel > 128 ? 128 : rel); s[r] += t2h[rel]; }
}
__device__ __forceinline__ void nsa_pv(const f32x16& s0, const f32x16& s1, f32x16& o0, f32x16& o1, const LAS unsigned char* vt, unsigned trb) {
#pragma unroll
    for (int kt = 0; kt < 2; ++kt)
#pragma unroll
        for (int s2 = 0; s2 < 2; ++s2) { const bf16x8 pb = pack8(kt ? s1 : s0, 8 * s2);
#pragma unroll
            for (int dt = 0; dt < 2; ++dt) { const LAS unsigned char* tp = vt + trb + (32 * kt + 16 * s2) * 144 + 64 * dt;
                const bf16x4 lo = __builtin_bit_cast(bf16x4, __builtin_amdgcn_ds_read_tr16_b64_v4i16((LAS v4i16_t*)tp)), hi = __builtin_bit_cast(bf16x4, __builtin_amdgcn_ds_read_tr16_b64_v4i16((LAS v4i16_t*)(tp + 8 * 144)));
                const bf16x8 va = (bf16x8){lo[0], lo[1], lo[2], lo[3], hi[0], hi[1], hi[2], hi[3]};
                if (dt == 0) o0 = mfma32(va, pb, o0); else o1 = mfma32(va, pb, o1); } }
}
__device__ __forceinline__ void nsa_softmax_pv(f32x16& s0, f32x16& s1, float cs, float& l, f32x16& o0, f32x16& o1, const LAS unsigned char* vt, unsigned trb) {
    const f32x2 c2 = (f32x2){cs, cs}; f32x2 acc2 = (f32x2){0.f, 0.f};
#pragma unroll
    for (int r = 0; r < 16; r += 2) { const f32x2 a = (f32x2){s0[r], s0[r + 1]} - c2, b = (f32x2){s1[r], s1[r + 1]} - c2;
        const f32x2 pa = (f32x2){fast_exp2(a.x), fast_exp2(a.y)}, pb = (f32x2){fast_exp2(b.x), fast_exp2(b.y)}; s0[r] = pa.x; s0[r + 1] = pa.y; s1[r] = pb.x; s1[r + 1] = pb.y; acc2 += pa + pb; }
    l += acc2.x + acc2.y;
    nsa_pv(s0, s1, o0, o1, vt, trb);
}

__device__ __forceinline__ void nsa_phase(Frame& F, const Args& A, const bool dry = false) {
    unsigned char* ws = F.ws; LAS unsigned char* lds = F.lds; int tid_ = F.tid; asm volatile("" : "+v"(tid_)); const int tid = tid_, lane = tid & 63;
    bf16* QA = (bf16*)(ws + WS_QA); const bf16* SK = (const bf16*)(ws + WS_SK); const bf16* SV = (const bf16*)(ws + WS_SV); const bf16* WK = (const bf16*)(ws + WS_WK); const bf16* WV = (const bf16*)(ws + WS_WV);
    const bf16* KC = (const bf16*)(ws + WS_KC); const bf16* VC = (const bf16*)(ws + WS_VC); const float* AG = (const float*)(ws + WS_AG);
    LAS float* lut = (LAS float*)(lds + NSA_LUT); LAS float* imp = (LAS float*)(lds + NSA_IMP);
    __syncthreads();
    { const float* lg = (const float*)(ws + WS_BIASLUT); for (int i = tid; i < 2066; i += NWAVES * 64) lut[i] = lg[i];
      LAS float* T2 = (LAS float*)(lds + NSA_T2); for (int i = tid; i < 8 * 640; i += NWAVES * 64) { const int h = i / 640, rel = i % 640 - 64; T2[i] = rel < 0 ? NEG_INF : (rel < 128 ? lg[h * 128 + rel] : (rel < 512 ? lg[2048 + h] : NEG_INF)); } }
    __syncthreads();
    for (int un = F.vcu; un < 2048; un += F.G) {
        int lane_o = lane; asm volatile("" : "+v"(lane_o));
        const int q = lane_o & 31, hh = lane_o >> 5, tl = q >> 2, hd = q & 3;
        int w_o = F.wave; asm volatile("" : "+s"(w_o)); const int w = w_o;
        const unsigned trb = (unsigned)(4 * hh + ((lane_o & 15) >> 2)) * 144u + (unsigned)(16 * ((lane_o >> 4) & 1) + 4 * (lane_o & 3)) * 2u;
        const int ix = (F.vcu & 31) + 32 * (un >> 8);
        const int kk = (ix >> 5) & 3, rr = ix & 31;
        const int qt = (F.G == 256) ? ((kk == 0) ? 127 - rr : (kk == 1) ? 64 + rr : (kk == 2) ? 63 - rr : rr) : 127 - (un >> 4), bg = (F.G == 256) ? 2 * (F.vcu >> 5) + (ix >> 7) : (un & 15), b = bg >> 1, g = bg & 1;
        const int t0 = qt * 64, tq = t0 + 8 * w + tl, head = 4 * g + hd; const size_t tokrow = (size_t)b * SEQ + tq;
        bf16x8 qf[4];
#pragma unroll
        for (int s = 0; s < 4; ++s) qf[s] = *(const GAS bf16x8*)(QA + tokrow * 512 + head * 64 + 16 * s + 8 * hh);
        const LAS float* lutH = lut + head * 128; const float farb = lut[2048 + head]; const LAS float* t2 = (const LAS float*)(lds + NSA_T2) + head * 640 + 64 - 4 * hh;
        const float g0 = AG[tokrow * 24 + head * 3 + 0], g1 = AG[tokrow * 24 + head * 3 + 1], g2 = AG[tokrow * 24 + head * 3 + 2];
#pragma unroll
        for (int i = 0; i < 16; ++i) imp[(8 * w) * 128 + i * 64 + lane] = 0.f;
        f32x16 of0 = zero16(), of1 = zero16();
        f32x16 s0, s1, o0, o1; float l; NsaRegs R; const float CSH = lut[2064];
        const int t1 = t0 + 63; const int nct = (t1 >= 31) ? ((((t1 - 31) >> 4) >> 6) + 1) : 0;
        const bf16* KCb = KC + (size_t)bg * 512 * 64; const bf16* VCb = VC + (size_t)bg * 512 * 64;
        l = 0.f;
        __syncthreads();
        if (nct > 0) nsa_issue(R, KCb, VCb, 0, 64, 0, false, tid);
        for (int ct = 0; ct < nct; ++ct) {
            const int buf = ct & 1; nsa_commit(lds, buf, R, false, tid); if (ct + 1 < nct) nsa_issue(R, KCb, VCb, (size_t)64 * (ct + 1), 64, 0, false, tid); __syncthreads();
            nsa_qk(s0, s1, lds + NSA_KT + buf * NSA_TB, qf, q, hh);
            const bool fast = (t0 + 8 * w) - (16 * (64 * ct + 63) + 31) >= 128; float cs = CSH;
            if (fast) cs = CSH - farb; else { const int relc = tq - 16 * (64 * ct + 4 * hh) - 31; nsa_mask_cmp(s0, 0, relc, t2 + 4 * hh); nsa_mask_cmp(s1, 1, relc, t2 + 4 * hh); }
            float ls = 0.f;
#pragma unroll
            for (int r = 0; r < 16; ++r) ls += fast_exp2(s0[r] - cs) + fast_exp2(s1[r] - cs);
            l += ls;
        }
        { const float lt = half_sum(l); const float inv = lt > 0.f ? 1.f / lt : 0.f;
          o0 = zero16(); o1 = zero16();
          __syncthreads();
          if (nct > 0) nsa_issue(R, KCb, VCb, 0, 64, 0, true, tid);
          for (int ct = 0; ct < nct; ++ct) {
            const int buf = ct & 1; nsa_commit(lds, buf, R, true, tid); if (ct + 1 < nct) nsa_issue(R, KCb, VCb, (size_t)64 * (ct + 1), 64, 0, true, tid); __syncthreads();
            nsa_qk(s0, s1, lds + NSA_KT + buf * NSA_TB, qf, q, hh);
            const bool fast = (t0 + 8 * w) - (16 * (64 * ct + 63) + 31) >= 128; float cs = CSH;
            if (fast) cs = CSH - farb; else { const int relc = tq - 16 * (64 * ct + 4 * hh) - 31; nsa_mask_cmp(s0, 0, relc, t2 + 4 * hh); nsa_mask_cmp(s1, 1, relc, t2 + 4 * hh); }
#pragma unroll
            for (int r = 0; r < 16; ++r) { s0[r] = fast_exp2(s0[r] - cs) * inv; s1[r] = fast_exp2(s1[r] - cs) * inv; }
#pragma unroll
            for (int kt = 0; kt < 2; ++kt)
#pragma unroll
                for (int gq = 0; gq < 4; ++gq) { const f32x16& p = kt ? s1 : s0; float a = (p[4 * gq] + p[4 * gq + 1]) + (p[4 * gq + 2] + p[4 * gq + 3]); float c3 = p[4 * gq + 3];
                    a += dpp_xor1(a); a += dpp_xor2(a); c3 += dpp_xor1(c3); c3 += dpp_xor2(c3);
                    const int jb = 16 * ct + 8 * kt + 2 * gq + hh;
                    if (hd == 0) { atomicAdd((float*)&imp[(8 * w + tl) * 128 + jb], a); if (jb + 1 < 128) atomicAdd((float*)&imp[(8 * w + tl) * 128 + jb + 1], c3); } }
            nsa_pv(s0, s1, o0, o1, lds + NSA_VT + buf * NSA_TB, trb);
          }
#pragma unroll
          for (int r = 0; r < 16; ++r) { of0[r] += g0 * o0[r]; of1[r] += g0 * o1[r]; }
        }
        LDS_WAIT();
        unsigned selw0 = 0u, selw1 = 0u, selw2 = 0u, selw3 = 0u;
        for (int i = 0; i < 8; ++i) {
            const int cur = qt; const int j0 = lane, j1 = lane + 64;
            const float v0 = imp[(8 * w + i) * 128 + j0], v1 = imp[(8 * w + i) * 128 + j1];
            const bool f0 = (j0 == 0) || (j0 == cur) || (j0 == cur - 1), f1 = (j1 == 0) || (j1 == cur) || (j1 == cur - 1);
            const float x0 = f0 ? 3.0e6f - (float)j0 : (j0 <= cur ? v0 : -1.0e6f - (float)j0), x1 = f1 ? 3.0e6f - (float)j1 : (j1 <= cur ? v1 : -1.0e6f - (float)j1);
            const unsigned k0 = ord_key(x0), k1 = ord_key(x1);
            unsigned pre = 0u;
            for (int bit = 31; bit >= 0; --bit) { const unsigned cand = pre | (1u << bit); const int cnt = __popcll(__ballot(k0 >= cand)) + __popcll(__ballot(k1 >= cand)); if (cnt >= 16) pre = cand; if (cnt == 16) break; }
            const unsigned long long mlo = __ballot(k0 >= pre), mhi = __ballot(k1 >= pre);
            if (tl == i) { selw0 = (unsigned)mlo; selw1 = (unsigned)(mlo >> 32); selw2 = (unsigned)mhi; selw3 = (unsigned)(mhi >> 32); }
        }
        l = 0.f; o0 = zero16(); o1 = zero16();
        __syncthreads();
        nsa_issue(R, SK, SV, (size_t)b * SEQ, 128, g * 64, true, tid);
        for (int j = 0; j <= qt; ++j) {
            const int buf = j & 1; nsa_commit(lds, buf, R, true, tid); if (j < qt) nsa_issue(R, SK, SV, (size_t)b * SEQ + 64 * (j + 1), 128, g * 64, true, tid); __syncthreads();
            const unsigned sw = (j < 32) ? selw0 : (j < 64) ? selw1 : (j < 96) ? selw2 : selw3; const bool lanesel = (sw >> (j & 31)) & 1u;
            if (!__any(lanesel)) continue;
            nsa_qk(s0, s1, lds + NSA_KT + buf * NSA_TB, qf, q, hh);
            float cs = CSH;
            if (j >= qt - 2) { const LAS float* tr = t2 + (lanesel ? tq - 64 * j : 4 * hh - 1); nsa_mask_tab(s0, 0, tr); nsa_mask_tab(s1, 1, tr); } else cs = lanesel ? CSH - farb : -NEG_INF;
            nsa_softmax_pv(s0, s1, cs, l, o0, o1, lds + NSA_VT + buf * NSA_TB, trb);
        }
        { const float lt = half_sum(l); const float sc = lt > 0.f ? g1 / lt : 0.f;
#pragma unroll
          for (int r = 0; r < 16; ++r) { of0[r] += sc * o0[r]; of1[r] += sc * o1[r]; } }
        l = 0.f; o0 = zero16(); o1 = zero16();
        { const int jf = qt > 8 ? qt - 8 : 0;
          __syncthreads();
          nsa_issue(R, WK, WV, (size_t)b * SEQ + 64 * jf, 128, g * 64, true, tid);
          for (int j = jf; j <= qt; ++j) {
            const int buf = j & 1; nsa_commit(lds, buf, R, true, tid); if (j < qt) nsa_issue(R, WK, WV, (size_t)b * SEQ + 64 * (j + 1), 128, g * 64, true, tid); __syncthreads();
            nsa_qk(s0, s1, lds + NSA_KT + buf * NSA_TB, qf, q, hh);
            float cs = CSH;
            if (j >= qt - 2 || j == qt - 8) { const LAS float* tr = t2 + (tq - 64 * j); nsa_mask_tab(s0, 0, tr); nsa_mask_tab(s1, 1, tr); } else cs = CSH - farb;
            nsa_softmax_pv(s0, s1, cs, l, o0, o1, lds + NSA_VT + buf * NSA_TB, trb);
          } }
        { const float lt = half_sum(l); const float sc = lt > 0.f ? g2 / lt : 0.f;
#pragma unroll
          for (int r = 0; r < 16; ++r) { of0[r] += sc * o0[r]; of1[r] += sc * o1[r]; } }
        bf16* op = QA + tokrow * 512 + head * 64;
        if (!dry)
#pragma unroll
        for (int gq = 0; gq < 4; ++gq) { v2u a; a.x = pg8::cvt_pk_bf16(of0[4 * gq], of0[4 * gq + 1]); a.y = pg8::cvt_pk_bf16(of0[4 * gq + 2], of0[4 * gq + 3]); *(GAS v2u*)(op + 8 * gq + 4 * hh) = a;
            v2u c; c.x = pg8::cvt_pk_bf16(of1[4 * gq], of1[4 * gq + 1]); c.y = pg8::cvt_pk_bf16(of1[4 * gq + 2], of1[4 * gq + 3]); *(GAS v2u*)(op + 32 + 8 * gq + 4 * hh) = c; }
    }
    __syncthreads();
}

constexpr int MCV_I1 = (1024 / 32) * (2048 / 64), MCV_I2 = (1024 / 32) * (1024 / 64), MCV_ITEMS = NEXP * (MCV_I1 + MCV_I2);
struct MoeCvt { float v[32]; bf16* dst; };
__device__ __forceinline__ void moe_cvt_issue(MoeCvt& C, Frame& F, int item, int lane) {
    const float* W; bf16* WT; int N, k0, n0;
    if (item < NEXP * MCV_I1) { const int e = item / MCV_I1, r = item % MCV_I1; N = 2048; W = INP(25) + (size_t)e * 1024 * 2048; WT = (bf16*)(F.ws + WS_W1T) + (size_t)e * 2048 * 1024; k0 = 32 * (r / 32); n0 = 64 * (r % 32); }
    else { const int x = item - NEXP * MCV_I1, e = x / MCV_I2, r = x % MCV_I2; N = 1024; W = INP(27) + (size_t)e * 1024 * 1024; WT = (bf16*)(F.ws + WS_W2T) + (size_t)e * 1024 * 1024; k0 = 32 * (r / 16); n0 = 64 * (r % 16); }
    const GAS float* src = (const GAS float*)(W + (size_t)k0 * N + n0 + lane);
#pragma unroll
    for (int j = 0; j < 32; ++j) C.v[j] = src[(size_t)j * N];
    C.dst = WT + (size_t)(n0 + lane) * 1024 + k0;
}
__device__ __forceinline__ void moe_cvt_finish(const MoeCvt& C) {
#pragma unroll
    for (int q4 = 0; q4 < 4; ++q4) { v4u o; o.x = pk2(C.v[8 * q4], C.v[8 * q4 + 1]); o.y = pk2(C.v[8 * q4 + 2], C.v[8 * q4 + 3]); o.z = pk2(C.v[8 * q4 + 4], C.v[8 * q4 + 5]); o.w = pk2(C.v[8 * q4 + 6], C.v[8 * q4 + 7]);
        *(GAS v4u*)(C.dst + 8 * q4) = o; }
}
constexpr int DS_PML = 0, DS_SELIDX = 4096, DS_CTRL = 8192, DS_WCNT = 8320, DS_EQ = 8448, DS_EQV = 10496, DS_PO = 12544  , DS_DUMMY = 28928  , DS_VT = 31744, DS_HIST = 31744  , DS_LUT = 115712;
__device__ __forceinline__ int dsa_scan32(int v) {
    v += __builtin_amdgcn_update_dpp(0, v, 0x111, 0xf, 0xf, false); v += __builtin_amdgcn_update_dpp(0, v, 0x112, 0xf, 0xf, false);
    v += __builtin_amdgcn_update_dpp(0, v, 0x114, 0xf, 0xf, false); v += __builtin_amdgcn_update_dpp(0, v, 0x118, 0xf, 0xf, false);
    v += __builtin_amdgcn_update_dpp(0, v, 0x142, 0xa, 0xf, false); return v; }
__device__ __forceinline__ int dsa_scan64(int v) { v = dsa_scan32(v); v += __builtin_amdgcn_update_dpp(0, v, 0x143, 0xc, 0xf, false); return v; }
__device__ __forceinline__ int dsa_key(float f) { const int k = (int)fmaf(f, 134217728.0f, 1073741824.0f); return k < 1 ? 1 : k; }
__device__ __forceinline__ void dsa_phase(Frame& F, const Args& A, const int dry = 0) {
    unsigned char* ws = F.ws; LAS unsigned char* lds = F.lds; int tid_ = F.tid; asm volatile("" : "+v"(tid_)); const int tid = tid_, lane = tid & 63;
    const bf16* IQ = (const bf16*)(ws + WS_IQ); const bf16* IK = (const bf16*)(ws + WS_IK); const float* IW = (const float*)(ws + WS_IW);
    bf16* QB = (bf16*)(ws + WS_QB); const bf16* KB = (const bf16*)(ws + WS_KB); const bf16* VB = (const bf16*)(ws + WS_VB);
    LAS int* hist = (LAS int*)(lds + DS_HIST); LAS int* selidx = (LAS int*)(lds + DS_SELIDX); LAS int* ctrl = (LAS int*)(lds + DS_CTRL); LAS int* eql = (LAS int*)(lds + DS_HIST); LAS int* eqk = (LAS int*)(lds + DS_HIST + 16384)    ;
    LAS int* wcnt = (LAS int*)(lds + DS_WCNT); LAS float* pml = (LAS float*)(lds + DS_PML); LAS float* po = (LAS float*)(lds + DS_PO); LAS float* lut = (LAS float*)(lds + DS_LUT);
    __syncthreads();
    { const float* lg = (const float*)(ws + WS_BIASLUT); for (int i = tid; i < 2066; i += NWAVES * 64) lut[i] = lg[i]; }
    __syncthreads();
    bf16x8 af_n[4]; f32x4 wv_n[4];
    auto dsa_qload = [&](int un_, int lane_x) {
        const int q_ = lane_x & 31, hh_ = lane_x >> 5;
        const int b_ = (F.G == 256) ? (F.vcu >> 5) : (un_ & 7), t0_ = (F.G == 256) ? 4 * (2047 - ((F.vcu & 31) + 32 * (un_ >> 8))) : 4 * (2047 - (un_ >> 3)); const size_t brow_ = (size_t)b_ * SEQ;
#pragma unroll
        for (int s = 0; s < 4; ++s) af_n[s] = *(const GAS bf16x8*)(IQ + (brow_ + t0_ + (((q_ >> 2) & 1) * 2 + (q_ >> 4))) * 512 + (((q_ >> 3) & 1) * 4 + (q_ & 3)) * 64 + 16 * s + 8 * hh_);
#pragma unroll
        for (int t = 0; t < 4; ++t) wv_n[t] = *(const GAS f32x4*)(IW + (brow_ + t0_ + 2 * hh_ + (t >> 1)) * 8 + 4 * (t & 1));
    };
    dsa_qload(F.vcu, lane);
    for (int un = F.vcu; un < NTOK / 4; un += F.G) {
        int lane_o = lane, tid_o = tid_; asm volatile("" : "+v"(lane_o), "+v"(tid_o));
        const int q = lane_o & 31, hh = lane_o >> 5; const int tid = tid_o;
        int w_o = F.wave; asm volatile("" : "+s"(w_o)); const int w = w_o;
        LAS unsigned char* vtb = lds + DS_VT + w * 10496;
        const int b = (F.G == 256) ? (F.vcu >> 5) : (un & 7), t0 = (F.G == 256) ? 4 * (2047 - ((F.vcu & 31) + 32 * (un >> 8))) : 4 * (2047 - (un >> 3)), tmax = t0 + 3; const size_t brow = (size_t)b * SEQ;
        bf16x8 af[4];
        float wv[16];
#pragma unroll
        for (int i = 0; i < 4; ++i) { af[i] = af_n[i]; wv[4 * i] = wv_n[i].x; wv[4 * i + 1] = wv_n[i].y; wv[4 * i + 2] = wv_n[i].z; wv[4 * i + 3] = wv_n[i].w; }
        int kq = 32 * w + q; asm volatile("" : "+v"(kq));
        const int nit = ((tmax >> 5) >= w) ? ((((tmax >> 5) - w) >> 3) + 1) : 0;
        int sk[32][2];
        bf16x8 bb[2][4];
        const bf16* pl = IK + ((((size_t)b * 256 + w) * 4) * 2 + hh) * 256 + q * 8;
#define DSA_LOADB(IT, ADV) do { if (ADV) { pl += 8 * 2048; } asm volatile("" : "+v"(pl)); _Pragma("unroll") for (int s = 0; s < 4; ++s) bb[(IT) & 1][s] = *(const GAS bf16x8*)(pl + 512 * s); } while (0)
        if (nit > 0) DSA_LOADB(0, false);
#pragma unroll
        for (int it = 0; it < 32; ++it) {
            if (it < nit) {
                if (it + 1 < 32) DSA_LOADB(it + 1, it + 1 < nit);
                f32x16 acc = zero16();
#pragma unroll
                for (int s = 0; s < 4; ++s) acc = mfma32h(af[s], bb[it & 1][s], acc);
                float ps[2];
#pragma unroll
                for (int t = 0; t < 2; ++t) { f32x2 a2 = (f32x2){relu_i(acc[8 * t]), relu_i(acc[8 * t + 1])} * (f32x2){wv[8 * t], wv[8 * t + 1]};
#pragma unroll
                    for (int j = 1; j < 4; ++j) a2 = (f32x2){relu_i(acc[8 * t + 2 * j]), relu_i(acc[8 * t + 2 * j + 1])} * (f32x2){wv[8 * t + 2 * j], wv[8 * t + 2 * j + 1]} + a2;
                    ps[t] = a2.x + a2.y; }
                int k0 = dsa_key(ps[0]), k1 = dsa_key(ps[1]);
                if (it == nit - 1) { asm volatile("" ::: "memory");     const int key = kq + 256 * it; k0 = key <= t0 + 2 * hh ? k0 : 0; k1 = key <= t0 + 2 * hh + 1 ? k1 : 0; }
                sk[it][0] = k0; sk[it][1] = k1;
            } else { sk[it][0] = 0; sk[it][1] = 0; }
            asm volatile("" ::: "memory");
        }
#undef DSA_LOADB
        MoeCvt mcv; const int mcv_item = ((un - F.vcu) / F.G) * (F.G * NWAVES) + F.vcu * NWAVES + w; const bool mcv_on = mcv_item < MCV_ITEMS && dry == 0;
        if (mcv_on) moe_cvt_issue(mcv, F, mcv_item, lane_o);
        if (dry == 2) { int acc_ = 0;
#pragma unroll
            for (int it = 0; it < 32; ++it) acc_ += sk[it][0] + sk[it][1];
            if (acc_ == 12345678) pml[lane] = 1.f; __syncthreads(); continue; }
        const bool selall = tmax <= 255;
        if (tid < 4) { ctrl[tid * 8 + 0] = 0; ctrl[tid * 8 + 1] = 256; ctrl[tid * 8 + 2] = 0; ctrl[tid * 8 + 3] = 0; }
        if (!selall) {
#pragma unroll
            for (int i = 0; i < 4; ++i) *(LAS v4u*)(lds + DS_HIST + (i * 512 + tid) * 16) = (v4u){0u, 0u, 0u, 0u}; }
        __syncthreads();
        if (!selall) {
            LAS int* h0 = hist + (2 * hh) * 2048; LAS int* h1 = h0 + 2048; int nitp = nit; asm volatile("" : "+s"(nitp));
#pragma unroll
            for (int it = 0; it < 32; ++it) { if (it < nitp) { atomicAdd((int*)&h0[sk[it][0] >> 20], 1); atomicAdd((int*)&h1[sk[it][1] >> 20], 1); } __builtin_amdgcn_sched_barrier(0); }
            __syncthreads();
            if (w < 4) { const int T = w; const int need = 256; const LAS v4u* hp = (const LAS v4u*)(hist + T * 2048 + 32 * lane);
                int tot = 0;
#pragma unroll
                for (int j = 0; j < 8; ++j) { const v4u c = hp[j]; tot += (int)(c.x + c.y + c.z + c.w); }
                const int pre = dsa_scan64(tot); const int suf = __builtin_amdgcn_readlane(pre, 63) - pre + tot;
                const int L = __builtin_amdgcn_readfirstlane(__popcll(__ballot(suf >= need)) - 1);
                { const int rem = need - __builtin_amdgcn_readlane(suf - tot, L);
                  const int cbin = hist[T * 2048 + 32 * L + (lane & 31)];
                  const int p32 = dsa_scan32(cbin); const int sfx = __builtin_amdgcn_readlane(p32, 31) - p32 + cbin;
                  const int d = __builtin_amdgcn_readfirstlane(__popc((unsigned)__ballot(sfx >= rem)) - 1);
                  const int nn = rem - __builtin_amdgcn_readlane(sfx - cbin, d);
                  if (lane == 0) { ctrl[T * 8 + 0] = 32 * L + d; ctrl[T * 8 + 1] = nn; } } }
            __syncthreads();
        }
        int idxbase = kq; asm volatile("" : "+v"(idxbase));
        const int th0 = selall ? -1 : ctrl[(2 * hh) * 8 + 0], th1 = selall ? -1 : ctrl[(2 * hh + 1) * 8 + 0];
        const int thr0 = selall ? 0 : (int)((((unsigned)th0 + 1u) << 20) - 1u), thr1 = selall ? 0 : (int)((((unsigned)th1 + 1u) << 20) - 1u);
        int lp0, lp1;
        { int n0 = 0, n1 = 0; int nitc = nit; asm volatile("" : "+s"(nitc));
#pragma unroll
          for (int it = 0; it < 32; ++it) { if (it < nitc) { n0 += sk[it][0] > thr0 ? 1 : 0; n1 += sk[it][1] > thr1 ? 1 : 0; } }
          const int i0 = dsa_scan32(n0), i1 = dsa_scan32(n1);
          lp0 = i0 - n0; lp1 = i1 - n1;
          if (q == 31) { wcnt[w * 4 + 2 * hh] = i0; wcnt[w * 4 + 2 * hh + 1] = i1; } }
        __syncthreads();
        int tot0 = 0, tot1 = 0, tot2 = 0, tot3 = 0, bs0 = 0, bs1 = 0, bs2 = 0, bs3 = 0;
#pragma unroll
        for (int ww = 0; ww < 8; ++ww) { const int a0 = wcnt[ww * 4 + 0], a1 = wcnt[ww * 4 + 1], a2 = wcnt[ww * 4 + 2], a3 = wcnt[ww * 4 + 3];
            tot0 += a0; tot1 += a1; tot2 += a2; tot3 += a3; if (ww < w) { bs0 += a0; bs1 += a1; bs2 += a2; bs3 += a3; } }
        { int thr0b = thr0, thr1b = thr1; asm volatile("" : "+v"(thr0b), "+v"(thr1b));
          const int tl0 = selall ? 0x7fffffff : ((th0 << 20) - 1 < 0 ? 0 : (th0 << 20) - 1), tl1 = selall ? 0x7fffffff : ((th1 << 20) - 1 < 0 ? 0 : (th1 << 20) - 1);
          LAS int* dummy = (LAS int*)(lds + DS_DUMMY) + tid;
          int run0 = (hh ? bs2 : bs0) + lp0, run1 = (hh ? bs3 : bs1) + lp1; int nite = nit; asm volatile("" : "+s"(nite));
          LAS int* sel0 = selidx + (2 * hh) * 256; LAS int* sel1 = selidx + (2 * hh + 1) * 256;
#pragma unroll
          for (int it = 0; it < 32; ++it) { if (it < nite) { const int idx = idxbase + 256 * it; const int k0 = sk[it][0], k1 = sk[it][1];
              const bool s0 = k0 > thr0b, s1 = k1 > thr1b;
              { LAS int* d0 = (s0 && run0 < 256) ? sel0 + run0 : dummy; LAS int* d1 = (s1 && run1 < 256) ? sel1 + run1 : dummy; *d0 = idx; *d1 = idx; }
              run0 += s0 ? 1 : 0; run1 += s1 ? 1 : 0;
              const bool e0 = !s0 && k0 > tl0, e1 = !s1 && k1 > tl1;
              if (__any(e0 || e1)) {
              if (e0) { const int p = atomicAdd((int*)&ctrl[(2 * hh) * 8 + 3], 1); if (p < 1024) { eql[(2 * hh) * 1024 + p] = idx; eqk[(2 * hh) * 1024 + p] = k0; } }
              if (e1) { const int p = atomicAdd((int*)&ctrl[(2 * hh + 1) * 8 + 3], 1); if (p < 1024) { eql[(2 * hh + 1) * 1024 + p] = idx; eqk[(2 * hh + 1) * 1024 + p] = k1; } } } }
              __builtin_amdgcn_sched_barrier(0); } }
        __syncthreads();
        if (w < 4) { const int T = w; const int totT = (T == 0) ? tot0 : (T == 1) ? tot1 : (T == 2) ? tot2 : tot3;
            if (!selall) { int ne = ctrl[T * 8 + 3]; ne = ne > 1024 ? 1024 : ne; const int need = ctrl[T * 8 + 1];
                for (int me = lane; me < ne; me += 64) { const int mine = eql[T * 1024 + me]; const int mv = eqk[T * 1024 + me]; int rank = 0;
                    for (int j = 0; j < ne; ++j) { const int vj = eqk[T * 1024 + j]; const int ij = eql[T * 1024 + j]; rank += (vj > mv || (vj == mv && ij < mine)) ? 1 : 0; }
                    if (rank < need && totT + rank < 256) selidx[T * 256 + totT + rank] = mine; }
                if (lane == 0) { const int nn = totT + (need < ne ? need : ne); ctrl[T * 8 + 2] = nn; } }
            else if (lane == 0) ctrl[T * 8 + 2] = totT; }
        __syncthreads();
        if (dry == 3) { __syncthreads(); continue; }
        if (mcv_on) moe_cvt_finish(mcv);
        if (un + F.G < NTOK / 4) dsa_qload(un + F.G, lane_o);
        { int lane_a = lane_o, t0_a = t0; asm volatile("" : "+v"(lane_a), "+s"(t0_a));
          const int q = lane_a & 31, hh = lane_a >> 5;
          const int T = w >> 1, hs = w & 1, tokq = t0_a + T; int n = ctrl[T * 8 + 2]; n = n > 256 ? 256 : n;
          const unsigned traddr = (unsigned)(8 * hh + ((lane_a & 15) >> 2)) * 144u + (unsigned)(16 * ((lane_a >> 4) & 1) + 4 * (lane_a & 3)) * 2u;
          v4u onesw; onesw.x = onesw.y = onesw.z = onesw.w = (q == 0) ? 0x3f803f80u : 0u; const bf16x8 onesf = __builtin_bit_cast(bf16x8, onesw);
          int ridx[4];
#pragma unroll
          for (int c = 0; c < 4; ++c) { const int slot = 128 * hs + 32 * c + q; ridx[c] = slot < n ? selidx[T * 256 + slot] : 0; }
          unsigned go[4][4];
#pragma unroll
          for (int c = 0; c < 4; ++c) {
#pragma unroll
              for (int i = 0; i < 4; ++i) { const int slot = 128 * hs + 32 * c + 8 * i + (lane_a >> 3); const int row = slot < n ? selidx[T * 256 + slot] : 0;
                  go[c][i] = (unsigned)row * 128u + (unsigned)((((lane_a & 7) ^ (4 * (i & 1) + (lane_a >> 4))) & 7) << 4); } }
          LAS unsigned char* kt = vtb; LAS unsigned char* vt = vtb + 4096; LAS unsigned short* ptw = (LAS unsigned short*)(vtb + 8192);
          const unsigned ktu = (unsigned)(size_t)kt, vtu = (unsigned)(size_t)vt;
          const char* kbase = (const char*)(KB + brow * 64); const char* vbase = (const char*)(VB + brow * 64);
          const int rr = (lane_a & 15) >> 2;
          unsigned tra[2][2];
#pragma unroll
          for (int nt = 0; nt < 2; ++nt) {
#pragma unroll
              for (int hi = 0; hi < 2; ++hi) { const int R0 = 8 * hh + rr + 4 * hi; const int seg = ((nt ^ hh) << 2) | ((((lane_a >> 4) & 1) ^ hi) << 1) | (((lane_a & 3) >> 1) ^ (rr >> 1));
                  tra[nt][hi] = (unsigned)(R0 * 128 + seg * 16 + 8 * (lane_a & 1)); } }
          unsigned kad[4];
#pragma unroll
          for (int ks = 0; ks < 4; ++ks) kad[ks] = (unsigned)(q * 128 + (((2 * ks + hh) ^ ((q >> 1) & 7)) << 4));
          bf16x8 qf[4];
#pragma unroll
          for (int ks = 0; ks < 4; ++ks) qf[ks] = *(const GAS bf16x8*)(QB + (brow + tokq) * 512 + (q & 7) * 64 + 16 * ks + 8 * hh);
#define DSA_GK(C) do { _Pragma("unroll") for (int i = 0; i < 4; ++i) pg8::glds16_s(kbase, go[C][i], ktu + (unsigned)(i * 1024)); } while (0)
#define DSA_GV(C) do { _Pragma("unroll") for (int i = 0; i < 4; ++i) pg8::glds16_s(vbase, go[C][i], vtu + (unsigned)(i * 1024)); } while (0)
          DSA_GK(0); DSA_GV(0);
          f32x16 o0 = zero16(), o1 = zero16(), o2 = zero16(); const float CSH = lut[2065];
          const float bfar0 = lut[2048 + 8 + 4 * hh], bfar1 = lut[2048 + 9 + 4 * hh], bfar2 = lut[2048 + 10 + 4 * hh], bfar3 = lut[2048 + 11 + 4 * hh];
#pragma unroll
          for (int c = 0; c < 4; ++c) {
              asm volatile("s_waitcnt vmcnt(0)" ::: "memory");
              bf16x8 kf[4], vb[2][2];
#pragma unroll
              for (int ks = 0; ks < 4; ++ks) kf[ks] = *(const LAS bf16x8*)(kt + kad[ks]);
#pragma unroll
              for (int s2 = 0; s2 < 2; ++s2) {
#pragma unroll
                  for (int nt = 0; nt < 2; ++nt) {
                      const bf16x4 lo = __builtin_bit_cast(bf16x4, __builtin_amdgcn_ds_read_tr16_b64_v4i16((LAS v4i16_t*)(vt + tra[nt][0] + s2 * 2048))), hi = __builtin_bit_cast(bf16x4, __builtin_amdgcn_ds_read_tr16_b64_v4i16((LAS v4i16_t*)(vt + tra[nt][1] + s2 * 2048)));
                      vb[s2][nt] = (bf16x8){lo[0], lo[1], lo[2], lo[3], hi[0], hi[1], hi[2], hi[3]}; } }
              LDS_WAIT();
              if (c < 3) { DSA_GK(c + 1); DSA_GV(c + 1); }
              f32x16 sc4 = zero16();
#pragma unroll
              for (int ks = 0; ks < 4; ++ks) sc4 = mfma32h(qf[ks], kf[ks], sc4);
              const int rel = tokq - ridx[c]; const bool valid = (128 * hs + 32 * c + q < n) && rel >= 0; const int ri = rel < 0 ? 0 : (rel > 127 ? 127 : rel);
              float sv[4];
              { const LAS float* lp = lut + (8 + 4 * hh) * 128 + ri; const bool nr = rel < 128;
                sv[0] = valid ? sc4[0] + (nr ? lp[0] : bfar0) : NEG_INF; sv[1] = valid ? sc4[1] + (nr ? lp[128] : bfar1) : NEG_INF; sv[2] = valid ? sc4[2] + (nr ? lp[256] : bfar2) : NEG_INF; sv[3] = valid ? sc4[3] + (nr ? lp[384] : bfar3) : NEG_INF; }
#pragma unroll
              for (int r = 0; r < 4; ++r) { const float p = fast_exp2(sv[r] - CSH); ptw[(4 * hh + r) * 40 + q] = (unsigned short)(pg8::cvt_pk_bf16(p, p) & 0xffffu); }
              LDS_WAIT();
              bf16x8 pa[2];
#pragma unroll
              for (int s2 = 0; s2 < 2; ++s2) { v4u z; z.x = z.y = z.z = z.w = 0u; pa[s2] = (q < 8) ? *(const LAS bf16x8*)(ptw + q * 40 + 16 * s2 + 8 * hh) : __builtin_bit_cast(bf16x8, z); }
#pragma unroll
              for (int s2 = 0; s2 < 2; ++s2) { o0 = mfma32(pa[s2], vb[s2][0], o0); o1 = mfma32(pa[s2], vb[s2][1], o1); o2 = mfma32(pa[s2], onesf, o2); }
          }
#undef DSA_GK
#undef DSA_GV
          { LAS float* op = po + (size_t)((T * 2 + hs) * 8 + 4 * hh) * 64 + q;
#pragma unroll
            for (int r = 0; r < 4; ++r) { op[r * 64] = o0[r]; op[r * 64 + 32] = o1[r]; }
            if (q == 0) {
#pragma unroll
                for (int r = 0; r < 4; ++r) { pml[((T * 2 + hs) * 8 + 4 * hh + r) * 2] = 0.f; pml[((T * 2 + hs) * 8 + 4 * hh + r) * 2 + 1] = o2[r]; } } } }
        __syncthreads();
        { const int T = tid >> 7, hd = (tid >> 4) & 7, d4 = (tid & 15) * 4;
          const float L = pml[((T * 2) * 8 + hd) * 2 + 1] + pml[((T * 2 + 1) * 8 + hd) * 2 + 1];
          const f32x4 O = *(const LAS f32x4*)(po + (size_t)((T * 2) * 8 + hd) * 64 + d4) + *(const LAS f32x4*)(po + (size_t)((T * 2 + 1) * 8 + hd) * 64 + d4);
          const float inv = L > 0.f ? 1.f / L : 0.f; v2u o; o.x = pg8::cvt_pk_bf16(O.x * inv, O.y * inv); o.y = pg8::cvt_pk_bf16(O.z * inv, O.w * inv);
          if (!dry) *(GAS v2u*)(QB + (brow + t0 + T) * 512 + hd * 64 + d4) = o; }
        __syncthreads();
    }
    __syncthreads();
}

constexpr int NPH = 12;
#ifndef MK_ONE_LAUNCH
#define MK_ONE_LAUNCH 0
#endif
#ifndef TEST_STAGE
#define TEST_STAGE 0
#endif

#define INP_ARG(i) (args.in[(i)])
template <int PHM, int MODE = 0> __global__ void __launch_bounds__(NWAVES * 64, 2) fwd(Args args) {
    extern __shared__ __attribute__((aligned(16))) unsigned char lds[];
    Frame F;
    F.lds = (LAS unsigned char*)lds;
    F.tid = threadIdx.x; F.lane = F.tid & 63; F.wave = __builtin_amdgcn_readfirstlane(F.tid >> 6);
    F.G = gridDim.x; { const int bx = blockIdx.x; F.vcu = (F.G % 8 == 0) ? (bx % 8) * (F.G / 8) + bx / 8 : bx; }
    F.ws = args.ws; F.ctl = (gu32*)(args.ws + WS_CTL); F.out = args.out; F.in = nullptr;
    unsigned char* ws = args.ws;
    volatile LAS unsigned* MISC = (volatile LAS unsigned*)(F.lds + MISC_OFF);
    for (int u = F.tid; u < (LDS_BYTES - LDSCTL_OFF) / 4; u += NWAVES * 64) ((LAS unsigned*)(F.lds + LDSCTL_OFF))[u] = 0u;
    if (F.tid < 29) ((LAS unsigned long long*)(F.lds + PTR_OFF))[F.tid] = (unsigned long long)INP_ARG(F.tid);
    __syncthreads();
    const int lo = args.ph_lo, hi = args.ph_hi;
    XcdBarrier bar; bar.bar = (unsigned*)(F.ctl + CW_BAR); bar.x = 0; bar.st = nullptr;
    if (hi - lo > 1) bar = xcd_barrier_post((unsigned*)(F.ctl + CW_BAR), MISC + 8);
#ifndef PH_MASK
#define PH_MASK 0xFFFF
#endif
#define IN(k) ((((PH_MASK & PHM) >> (k)) & 1) && lo <= (k) && (k) < hi)
#define BOTH(k) (IN(k) && IN((k) + 1))
#ifndef DUP_MASK
#define DUP_MASK 0
#endif
#define ARG_MODE MODE
#ifndef PROBE_PH
#define PROBE_PH -1
#endif
#ifndef PROBE_MODE
#define PROBE_MODE 1
#endif
#ifdef PROBE_DUP
#define NREP(k) (1 + ((args.dup >> (k)) & 1))
#else
#define NREP(k) 1
#endif
#define GRID_BAR() xcd_barrier(bar)

    if (IN(0)) { p0_prologue(F, args); if (BOTH(0)) GRID_BAR(); }

#if TEST_STAGE != 1
    if (IN(1)) {
        pg8::Gemm g{(const bf16*)(ws + WS_XN), (const bf16*)(ws + WS_WIN), NTOK, NPIN, DM}; pg8::StaticOrder S; S.init(NTOK, NPIN, F.G, (int)blockIdx.x);
        pg8::EpiInProj E{ws, INP(3), INP(16), INP(4)};
        pg8::gemm_phase<pg8::EpiInProj, pg8::StaticOrder, 1024, true, false>(F.lds + RING_OFF, g, S, E);
        if (BOTH(1)) GRID_BAR();
    }
    if (IN(2)) { small_phase(F, args); if (BOTH(2)) GRID_BAR(); }
    if (IN(3)) { nsa_phase(F, args, ARG_MODE != 0); }
    if (IN(4)) { dsa_phase(F, args, ARG_MODE); if (BOTH(4)) GRID_BAR(); }
    if (IN(5)) { {
        { pg8::Gemm g{(const bf16*)(ws + WS_QA), (const bf16*)(ws + WS_WA), NTOK, DM, 512}; pg8::StaticOrder S; S.init(NTOK, DM, F.G, (int)blockIdx.x);
          pg8::EpiMerge<0> E{(const bf16*)(ws + WS_GA), (bf16*)(ws + WS_XN)};
          pg8::gemm_phase<pg8::EpiMerge<0>, pg8::StaticOrder, 512, true, false>(F.lds + RING_OFF, g, S, E); }
        { pg8::Gemm g{(const bf16*)(ws + WS_QB), (const bf16*)(ws + WS_WB), NTOK, DM, 512}; pg8::StaticOrder S; S.init(NTOK, DM, F.G, (int)blockIdx.x);
          pg8::EpiMerge<1> E{(const bf16*)(ws + WS_GB), (bf16*)(ws + WS_XN)};
          pg8::gemm_phase<pg8::EpiMerge<1>, pg8::StaticOrder, 512, true, false>(F.lds + RING_OFF, g, S, E); } }
        if (BOTH(5)) GRID_BAR();
    }
    if (IN(6)) {
        pg8::Gemm g{(const bf16*)(ws + WS_XN), (const bf16*)(ws + WS_WO), NTOK, DM, DM}; pg8::StaticOrder S; S.init(NTOK, DM, F.G, (int)blockIdx.x);
        pg8::EpiOut E{INP(0), args.out};
        pg8::gemm_phase<pg8::EpiOut, pg8::StaticOrder, 1024, true, false>(F.lds + RING_OFF, g, S, E);
        if (BOTH(6)) GRID_BAR();
    }
#else
    if (IN(6)) {
        const f32x4* src = (const f32x4*)INP(0); f32x4* dst = (f32x4*)args.out;
        for (size_t i = (size_t)blockIdx.x * (NWAVES * 64) + F.tid; i < (size_t)NTOK * DM / 4; i += (size_t)F.G * NWAVES * 64) dst[i] = src[i];
        if (BOTH(6)) GRID_BAR();
    }
#endif
    if (IN(7)) { router_phase(F, args, ARG_MODE != 0); if (BOTH(7)) GRID_BAR(); }
    if (IN(8)) { dispatch_phase(F); if (BOTH(8)) GRID_BAR(); }
    if (IN(9)) {
        const int T = __builtin_amdgcn_readfirstlane(((const int*)(ws + WS_TILEE))[2048]);
        LAS int* te = (LAS int*)(F.lds + RING_BYTES + 9216); __syncthreads(); { int t_ = tid_now(F.wave); asm volatile("" : "+v"(t_)); for (int i = t_; i < T; i += NWAVES * 64) te[i] = ((const int*)(ws + WS_TILEE))[i]; } __syncthreads();
        pg8::Gemm g{(const bf16*)(ws + WS_XN), (const bf16*)(ws + WS_W1T), T * 256, 2048, DM}; pg8::MoeOrder S; S.init(T, 8, F.G, (int)blockIdx.x, te);
        pg8::EpiSwiglu E{(bf16*)(ws + WS_ACT), INP(26)};
        pg8::gemm_phase<pg8::EpiSwiglu, pg8::MoeOrder, 1024, true, true>(F.lds + RING_OFF, g, S, E, (const int*)(ws + WS_ROWTOK));
        if (BOTH(9)) GRID_BAR();
    }
    if (IN(10)) {
        const int T = __builtin_amdgcn_readfirstlane(((const int*)(ws + WS_TILEE))[2048]);
        LAS int* te = (LAS int*)(F.lds + RING_BYTES + 9216); __syncthreads(); { int t_ = tid_now(F.wave); asm volatile("" : "+v"(t_)); for (int i = t_; i < T; i += NWAVES * 64) te[i] = ((const int*)(ws + WS_TILEE))[i]; } __syncthreads();
        pg8::Gemm g{(const bf16*)(ws + WS_ACT), (const bf16*)(ws + WS_W2T), T * 256, 1024, DEXP}; pg8::MoeRowOrder S; S.init(T, 4, F.G, (int)blockIdx.x, te);
        pg8::EpiDown E{(bf16*)(ws + WS_XN), (bf16*)(ws + WS_ACT), (bf16*)(ws + WS_YX), INP(28), (const float*)(ws + WS_ROWGATE), (T / 256) * 256, ARG_MODE != 0};
        pg8::gemm_phase<pg8::EpiDown, pg8::MoeRowOrder, 1024, true, false>(F.lds + RING_OFF, g, S, E);
        if (BOTH(10)) GRID_BAR();
    }
    if (IN(11)) { combine_phase(F, ARG_MODE != 0); }
#undef IN
#undef BOTH
#undef GRID_BAR
}

extern "C" void kernel_launch(void* const* d_in, const int* in_sizes, int n_in, void* d_out, int out_size, void* d_ws, size_t ws_size, hipStream_t stream) {
    static int grid = 0;
    if (grid == 0) {
        if (n_in != 29 || in_sizes[0] != NTOK * DM || out_size != NTOK * DM || ws_size < WS_END) { fprintf(stderr, "kernel_launch: unexpected shapes (n_in %d, in0 %d, out %d, ws %zu); nothing launched\n", n_in, n_in > 0 ? in_sizes[0] : -1, out_size, ws_size); grid = -1; return; }
        int dev = 0, cus = 0;
        if (hipGetDevice(&dev) != hipSuccess || hipDeviceGetAttribute(&cus, hipDeviceAttributeMultiprocessorCount, dev) != hipSuccess) { grid = -1; return; }
        grid = cus;
        if (grid != 256) { fprintf(stderr, "kernel_launch: built for 256 CUs (got %d)\n", grid); grid = -1; return; }
    }
    if (grid < 0) return;
    if (hipMemsetAsync((char*)d_ws + WS_CTL, 0, CTL_ZERO_BYTES, stream) != hipSuccess) return;
    Args a{};
    for (int i = 0; i < 29; ++i) a.in[i] = (const float*)d_in[i];
    a.out = (float*)d_out; a.ws = (unsigned char*)d_ws;
#define LAUNCH(MASK, LO, HI) do { static bool attr_set = false; if (!attr_set) { (void)hipFuncSetAttribute((const void*)fwd<MASK>, hipFuncAttributeMaxDynamicSharedMemorySize, LDS_BYTES); attr_set = true; } \
        a.ph_lo = (LO); a.ph_hi = (HI); hipLaunchKernelGGL(fwd<MASK>, dim3(grid), dim3(NWAVES * 64), LDS_BYTES, stream, a); } while (0)
#if MK_ONE_LAUNCH
    LAUNCH(0xFFF, 0, NPH);
#else
#define PL(MASK, P) do { LAUNCH(MASK, P, (P) + 1); if (PROBE_PH == (P)) { static bool as2 = false; if (!as2) { (void)hipFuncSetAttribute((const void*)fwd<MASK, PROBE_MODE>, hipFuncAttributeMaxDynamicSharedMemorySize, LDS_BYTES); as2 = true; } a.ph_lo = (P); a.ph_hi = (P) + 1; hipLaunchKernelGGL((fwd<MASK, PROBE_MODE>), dim3(grid), dim3(NWAVES * 64), LDS_BYTES, stream, a); } } while (0)
    PL(0x001, 0); PL(0x002, 1); PL(0x004, 2); PL(0x008, 3); PL(0x010, 4); PL(0x020, 5); PL(0x040, 6); PL(0x080, 7); PL(0x100, 8); PL(0x200, 9); PL(0x400, 10); PL(0x800, 11);
#undef PL
#endif
#undef LAUNCH
}
```
